# Optimizing an MI355X kernel written in HIP

```python
import jax, jax.numpy as jnp
from jax import lax
import numpy as np

D_MODEL = 1024
BATCH = 8
SEQ = 4096
DEPTH = 4

HEAD_DIM = D_MODEL // 16
SB_HEADS = 6
ML_HEADS = 6
SG_GROUPS = 4
SB_WIDTH = SB_HEADS * HEAD_DIM
ML_WIDTH = ML_HEADS * HEAD_DIM
SG_WIDTH = SG_GROUPS * HEAD_DIM
MIX_HEADS = SB_HEADS + ML_HEADS + SG_GROUPS
MIX_WIDTH = SB_WIDTH + ML_WIDTH + SG_WIDTH
IN_SIZES = (SB_WIDTH, SB_WIDTH, SB_WIDTH, 2 * ML_WIDTH, ML_WIDTH, ML_WIDTH, ML_HEADS, ML_HEADS, 2 * SG_WIDTH)
IN_WIDTH = sum(IN_SIZES)
Q_BLOCK = 128
ML_CHUNK = 128
SG_CHUNK = 128
CONV_WIDTH = 4
PEER_HEADS = 8
PEER_NKEYS = 128
PEER_EXPERTS = PEER_NKEYS * PEER_NKEYS
PEER_SUBDIM = 128
PEER_TOPK = 16
PEER_BLOCK = 128
NORM_EPS = 1e-6

kernel_name = "hybrid_sb_mlstm_sgmlp_peer"


def rms_norm(x, g):
    x32 = x.astype(jnp.float32)
    return x32 * lax.rsqrt(jnp.mean(x32 * x32, axis=-1, keepdims=True) + NORM_EPS) * g.astype(jnp.float32)


def split_heads(t, n_heads):
    b, s, _ = t.shape
    return t.reshape(b, s, n_heads, HEAD_DIM).transpose(0, 2, 1, 3)


def causal_conv(t, w, b):
    s = t.shape[1]
    tp = jnp.pad(t, ((0, 0), (CONV_WIDTH - 1, 0), (0, 0)))
    out = b.astype(jnp.float32)
    for j in range(CONV_WIDTH):
        out = out + tp[:, j:j + s] * w[j]
    return out


def stick_breaking_attention(q, k, v):
    s_len = q.shape[2]
    scale = HEAD_DIM ** -0.5
    outs = []
    for blk in range(s_len // Q_BLOCK):
        start = blk * Q_BLOCK
        end = start + Q_BLOCK
        z = jnp.einsum('bhqd,bhkd->bhqk', q[:, :, start:end], k[:, :, :end]) * scale
        before = jnp.arange(end)[None, :] < (start + jnp.arange(Q_BLOCK))[:, None]
        log_keep = jnp.where(before, -jax.nn.softplus(z), 0.0)
        log_keep_after = lax.cumsum(log_keep, axis=3, reverse=True) - log_keep
        w = jnp.where(before, jnp.exp(jax.nn.log_sigmoid(z) + log_keep_after), 0.0)
        outs.append(jnp.einsum('bhqk,bhkd->bhqd', w, v[:, :, :end]))
    return jnp.concatenate(outs, axis=2)


def mlstm_chunkwise(q, k, v, i_pre, f_pre):
    b, h, s_len, d = q.shape
    nc = s_len // ML_CHUNK
    log_f = jax.nn.log_sigmoid(f_pre)

    def chunks(t):
        return jnp.moveaxis(t.reshape(b, h, nc, ML_CHUNK, *t.shape[3:]), 2, 0)

    tril = jnp.tril(jnp.ones((ML_CHUNK, ML_CHUNK), dtype=bool))

    def step(carry, inp):
        c_mat, n_vec, m = carry
        qc, kc, vc, ic, lfc = inp
        bcum = jnp.cumsum(lfc, axis=-1)
        dmat = jnp.where(tril, bcum[..., :, None] - bcum[..., None, :] + ic[..., None, :], -jnp.inf)
        m_inter = bcum + m[..., None]
        m_t = jnp.maximum(m_inter, jnp.max(dmat, axis=-1))
        inter_scale = jnp.exp(m_inter - m_t)
        qk = jnp.einsum('bhtd,bhsd->bhts', qc, kc) * jnp.exp(dmat - m_t[..., None])
        num = jnp.einsum('bhts,bhsd->bhtd', qk, vc) + inter_scale[..., None] * jnp.einsum('bhtd,bhde->bhte', qc, c_mat)
        den = jnp.sum(qk, axis=-1) + inter_scale * jnp.einsum('bhtd,bhd->bht', qc, n_vec)
        h_out = num / jnp.maximum(jnp.abs(den), jnp.exp(-m_t))[..., None]
        b_last = bcum[..., -1]
        g_s = b_last[..., None] - bcum + ic
        m_new = jnp.maximum(b_last + m, jnp.max(g_s, axis=-1))
        w_s = jnp.exp(g_s - m_new[..., None])
        decay = jnp.exp(b_last + m - m_new)
        c_new = decay[..., None, None] * c_mat + jnp.einsum('bhs,bhsd,bhse->bhde', w_s, kc, vc)
        n_new = decay[..., None] * n_vec + jnp.einsum('bhs,bhsd->bhd', w_s, kc)
        return (c_new, n_new, m_new), h_out

    init = (jnp.zeros((b, h, d, d), jnp.float32), jnp.zeros((b, h, d), jnp.float32), jnp.zeros((b, h), jnp.float32))
    _, hs = lax.scan(step, init, (chunks(q), chunks(k), chunks(v), chunks(i_pre), chunks(log_f)))
    return jnp.moveaxis(hs, 0, 2).reshape(b, h, s_len, d)


def spatial_gating(u, v, w_s, b_s):
    b, s_len, _ = u.shape
    nc = s_len // SG_CHUNK
    tril = jnp.tril(jnp.ones((SG_CHUNK, SG_CHUNK), dtype=jnp.float32))
    v5 = v.reshape(b, nc, SG_CHUNK, SG_GROUPS, HEAD_DIM)
    gate = jnp.einsum('gts,bcsgd->bctgd', w_s.astype(jnp.float32) * tril, v5) + b_s.astype(jnp.float32).T[:, :, None]
    return (u.reshape(b, nc, SG_CHUNK, SG_GROUPS, HEAD_DIM) * gate).reshape(b, s_len, SG_GROUPS, HEAD_DIM)


def mixing_sublayer(xn, w_in, sb_qn_g, sb_kn_g, ml_conv_w, ml_conv_b, ml_i_b, ml_f_b,
                    sg_vn_g, sg_w, sg_b, out_g, w_out):
    b, s_len, _ = xn.shape
    z = jnp.matmul(xn, w_in).astype(jnp.float32)
    cuts = [int(c) for c in np.cumsum(IN_SIZES)[:-1]]
    sb_q, sb_k, sb_v, ml_qk, ml_v, ml_o, ml_i, ml_f, sg_uv = jnp.split(z, cuts, axis=-1)
    head_g = out_g.astype(jnp.float32).reshape(MIX_HEADS, HEAD_DIM)

    q = rms_norm(split_heads(sb_q, SB_HEADS), sb_qn_g)
    k = rms_norm(split_heads(sb_k, SB_HEADS), sb_kn_g)
    y_sb = stick_breaking_attention(q, k, split_heads(sb_v, SB_HEADS)).transpose(0, 2, 1, 3)
    y_sb = rms_norm(y_sb, head_g[:SB_HEADS])

    qk = jax.nn.silu(causal_conv(ml_qk, ml_conv_w.astype(jnp.float32), ml_conv_b))
    mq = split_heads(qk[..., :ML_WIDTH], ML_HEADS)
    mk = split_heads(qk[..., ML_WIDTH:], ML_HEADS) * (HEAD_DIM ** -0.5)
    i_pre = (ml_i + ml_i_b.astype(jnp.float32)).transpose(0, 2, 1)
    f_pre = (ml_f + ml_f_b.astype(jnp.float32)).transpose(0, 2, 1)
    y_ml = mlstm_chunkwise(mq, mk, split_heads(ml_v, ML_HEADS), i_pre, f_pre).transpose(0, 2, 1, 3)
    o_gate = jax.nn.sigmoid(ml_o).reshape(b, s_len, ML_HEADS, HEAD_DIM)
    y_ml = rms_norm(y_ml, head_g[SB_HEADS:SB_HEADS + ML_HEADS]) * o_gate

    uv = jax.nn.gelu(sg_uv)
    u = uv[..., :SG_WIDTH]
    v = rms_norm(uv[..., SG_WIDTH:].reshape(b, s_len, SG_GROUPS, HEAD_DIM),
                 sg_vn_g.reshape(SG_GROUPS, HEAD_DIM)).reshape(b, s_len, SG_WIDTH)
    y_sg = rms_norm(spatial_gating(u, v, sg_w, sg_b), head_g[SB_HEADS + ML_HEADS:])

    y = jnp.concatenate([y_sb, y_ml, y_sg], axis=2).reshape(b, s_len, MIX_WIDTH)
    return jnp.matmul(y.astype(xn.dtype), w_out)


def peer_ffn(xn, wq, sub_keys, u_tab, v_tab):
    b, s_len, d = xn.shape
    t = b * s_len
    xt = xn.reshape(t, d)
    q = jnp.matmul(xt, wq).astype(jnp.float32).reshape(t, PEER_HEADS, 2, PEER_SUBDIM)
    scores = jnp.einsum('thcd,hcnd->thcn', q, sub_keys.astype(jnp.float32))
    sv, si = lax.top_k(scores, PEER_TOPK)
    cand_s = (sv[:, :, 0, :, None] + sv[:, :, 1, None, :]).reshape(t, PEER_HEADS, PEER_TOPK * PEER_TOPK)
    cand_i = (si[:, :, 0, :, None] * PEER_NKEYS + si[:, :, 1, None, :]).reshape(t, PEER_HEADS, PEER_TOPK * PEER_TOPK)
    best_s, best_p = lax.top_k(cand_s, PEER_TOPK)
    idx = jnp.take_along_axis(cand_i, best_p, axis=-1)
    gate = jax.nn.softmax(best_s, axis=-1)
    nb = t // PEER_BLOCK

    def expert_block(args):
        xb, ib, gb = args
        act = jnp.einsum('td,thkd->thk', xb.astype(jnp.float32), u_tab[ib].astype(jnp.float32))
        wgt = jax.nn.gelu(act) * gb
        return jnp.einsum('thk,thkd->td', wgt, v_tab[ib].astype(jnp.float32))

    y = lax.map(expert_block, (xt.reshape(nb, PEER_BLOCK, d),
                               idx.reshape(nb, PEER_BLOCK, PEER_HEADS, PEER_TOPK),
                               gate.reshape(nb, PEER_BLOCK, PEER_HEADS, PEER_TOPK)))
    return y.reshape(b, s_len, d)


def setup_inputs(seed: int = 0) -> dict:
    key = jax.random.key(seed)
    ks = jax.random.split(key, 20)
    f32 = jnp.float32
    nrm = lambda k, shape, scale: jax.random.normal(k, shape, f32) * scale
    return {
        "x": nrm(ks[0], (BATCH, SEQ, D_MODEL), 1.0),
        "norm1_g": 1.0 + nrm(ks[1], (DEPTH, D_MODEL), 0.02),
        "w_in": nrm(ks[2], (DEPTH, D_MODEL, IN_WIDTH), D_MODEL ** -0.5),
        "sb_qn_g": 1.0 + nrm(ks[3], (DEPTH, HEAD_DIM), 0.02),
        "sb_kn_g": 1.0 + nrm(ks[4], (DEPTH, HEAD_DIM), 0.02),
        "ml_conv_w": nrm(ks[5], (DEPTH, CONV_WIDTH, 2 * ML_WIDTH), CONV_WIDTH ** -0.5),
        "ml_conv_b": nrm(ks[6], (DEPTH, 2 * ML_WIDTH), 0.02),
        "ml_i_b": nrm(ks[7], (DEPTH, ML_HEADS), 0.1),
        "ml_f_b": jnp.linspace(3.0, 6.0, ML_HEADS, dtype=f32)[None, :] + nrm(ks[8], (DEPTH, ML_HEADS), 0.02),
        "sg_vn_g": 1.0 + nrm(ks[9], (DEPTH, SG_WIDTH), 0.02),
        "sg_w": nrm(ks[10], (DEPTH, SG_GROUPS, SG_CHUNK, SG_CHUNK), SG_CHUNK ** -0.5),
        "sg_b": 1.0 + nrm(ks[11], (DEPTH, SG_GROUPS, SG_CHUNK), 0.02),
        "out_g": 1.0 + nrm(ks[12], (DEPTH, MIX_WIDTH), 0.02),
        "w_out": nrm(ks[13], (DEPTH, MIX_WIDTH, D_MODEL), MIX_WIDTH ** -0.5),
        "norm2_g": 1.0 + nrm(ks[14], (DEPTH, D_MODEL), 0.02),
        "peer_wq": nrm(ks[15], (DEPTH, D_MODEL, PEER_HEADS * 2 * PEER_SUBDIM), D_MODEL ** -0.5),
        "peer_keys": nrm(ks[16], (DEPTH, PEER_HEADS, 2, PEER_NKEYS, PEER_SUBDIM), PEER_SUBDIM ** -0.5),
        "peer_u": nrm(ks[17], (DEPTH, PEER_EXPERTS, D_MODEL), D_MODEL ** -0.5),
        "peer_v": nrm(ks[18], (DEPTH, PEER_EXPERTS, D_MODEL), (PEER_HEADS * PEER_TOPK) ** -0.5),
    }


def reference(x, norm1_g, w_in, sb_qn_g, sb_kn_g, ml_conv_w, ml_conv_b, ml_i_b, ml_f_b,
              sg_vn_g, sg_w, sg_b, out_g, w_out, norm2_g, peer_wq, peer_keys, peer_u, peer_v):
    for l in range(DEPTH):
        xn = rms_norm(x, norm1_g[l]).astype(x.dtype)
        x = x + mixing_sublayer(xn, w_in[l], sb_qn_g[l], sb_kn_g[l], ml_conv_w[l], ml_conv_b[l],
                                ml_i_b[l], ml_f_b[l], sg_vn_g[l], sg_w[l], sg_b[l], out_g[l],
                                w_out[l]).astype(x.dtype)
        xn = rms_norm(x, norm2_g[l]).astype(x.dtype)
        x = x + peer_ffn(xn, peer_wq[l], peer_keys[l], peer_u[l], peer_v[l]).astype(x.dtype)
    return x
```

```cpp
#include <hip/hip_runtime.h>
#include <stdint.h>
#include <math.h>

constexpr int B_ = 8, S_ = 4096, D_ = 1024, T_ = B_ * S_, DEPTH_ = 4;
constexpr int INW = 3212;
constexpr int ZQ = 0, ZK = 384, ZV = 768, ZMQ = 1152, ZMV = 1920, ZMO = 2304, ZMI = 2688, ZMF = 2694, ZSU = 2700, ZSV = 2956;
constexpr float EPS = 1e-6f;

__device__ __forceinline__ float wave_sum(float v) {
#pragma unroll
    for (int o = 32; o > 0; o >>= 1) v += __shfl_xor(v, o, 64);
    return v;
}
__device__ __forceinline__ float gelu_tanh(float x) {
    return 0.5f * x * (1.f + tanhf(0.7978845608028654f * (x + 0.044715f * x * x * x)));
}
__device__ __forceinline__ float softplus_f(float z) { return fmaxf(z, 0.f) + log1pf(expf(-fabsf(z))); }
__device__ __forceinline__ float logsigmoid_f(float z) { return fminf(z, 0.f) - log1pf(expf(-fabsf(z))); }

__global__ __launch_bounds__(256) void k_rmsnorm(const float* __restrict__ x, const float* __restrict__ g, float* __restrict__ out) {
    const int row = blockIdx.x * 4 + (threadIdx.x >> 6), lane = threadIdx.x & 63;
    const float4* xr = (const float4*)(x + (size_t)row * D_);
    const float4* g4 = (const float4*)g;
    float4 v[4]; float ss = 0.f;
#pragma unroll
    for (int i = 0; i < 4; ++i) { v[i] = xr[lane + 64 * i]; ss += v[i].x * v[i].x + v[i].y * v[i].y + v[i].z * v[i].z + v[i].w * v[i].w; }
    ss = wave_sum(ss);
    const float r = rsqrtf(ss * (1.f / D_) + EPS);
    float4* o4 = (float4*)(out + (size_t)row * D_);
#pragma unroll
    for (int i = 0; i < 4; ++i) { float4 gg = g4[lane + 64 * i]; o4[lane + 64 * i] = make_float4(v[i].x * r * gg.x, v[i].y * r * gg.y, v[i].z * r * gg.z, v[i].w * r * gg.w); }
}

template <bool RES>
__global__ __launch_bounds__(256) void k_gemm(const float* __restrict__ A, const float* __restrict__ Bm, const float* R, float* C, int M, int N, int K, int ldb, int ldc) {
    __shared__ float As[16][68];
    __shared__ float Bs[16][64];
    const int tid = threadIdx.x, tx = tid & 15, ty = tid >> 4;
    const int m0 = blockIdx.y * 64, n0 = blockIdx.x * 64;
    float acc[4][4];
#pragma unroll
    for (int i = 0; i < 4; ++i)
#pragma unroll
        for (int j = 0; j < 4; ++j) acc[i][j] = 0.f;
    for (int k0 = 0; k0 < K; k0 += 16) {
        {
            const int r = tid >> 2, c = (tid & 3) * 4;
            const float4 a = *(const float4*)(A + (size_t)(m0 + r) * K + k0 + c);
            As[c][r] = a.x; As[c + 1][r] = a.y; As[c + 2][r] = a.z; As[c + 3][r] = a.w;
        }
        {
            const int r = tid >> 4, c = (tid & 15) * 4, n = n0 + c;
            const float* bp = Bm + (size_t)(k0 + r) * ldb + n;
            float4 b;
            if (n + 3 < N) b = *(const float4*)bp;
            else { b.x = n < N ? bp[0] : 0.f; b.y = n + 1 < N ? bp[1] : 0.f; b.z = n + 2 < N ? bp[2] : 0.f; b.w = 0.f; }
            Bs[r][c] = b.x; Bs[r][c + 1] = b.y; Bs[r][c + 2] = b.z; Bs[r][c + 3] = b.w;
        }
        __syncthreads();
#pragma unroll
        for (int kk = 0; kk < 16; ++kk) {
            float a[4], b[4];
#pragma unroll
            for (int i = 0; i < 4; ++i) a[i] = As[kk][ty * 4 + i];
#pragma unroll
            for (int j = 0; j < 4; ++j) b[j] = Bs[kk][tx * 4 + j];
#pragma unroll
            for (int i = 0; i < 4; ++i)
#pragma unroll
                for (int j = 0; j < 4; ++j) acc[i][j] += a[i] * b[j];
        }
        __syncthreads();
    }
#pragma unroll
    for (int i = 0; i < 4; ++i)
#pragma unroll
        for (int j = 0; j < 4; ++j) {
            const int n = n0 + tx * 4 + j; const size_t o = (size_t)(m0 + ty * 4 + i) * ldc + n;
            if (n < N) C[o] = acc[i][j] + (RES ? R[o] : 0.f);
        }
}

__global__ __launch_bounds__(256) void k_sb_prep(const float* __restrict__ z, const float* __restrict__ qg, const float* __restrict__ kg,
                                                 float* __restrict__ qh, float* __restrict__ kh, float* __restrict__ vh) {
    const int w = blockIdx.x * 4 + (threadIdx.x >> 6), lane = threadIdx.x & 63;
    const int t = w / 6, h = w % 6, b = t / S_, s = t % S_;
    const float* zr = z + (size_t)t * INW;
    const float q = zr[ZQ + h * 64 + lane], k = zr[ZK + h * 64 + lane], v = zr[ZV + h * 64 + lane];
    const float sq = wave_sum(q * q), sk = wave_sum(k * k);
    const size_t o = (((size_t)b * 6 + h) * S_ + s) * 64 + lane;
    qh[o] = q * rsqrtf(sq * (1.f / 64) + EPS) * qg[lane];
    kh[o] = k * rsqrtf(sk * (1.f / 64) + EPS) * kg[lane];
    vh[o] = v;
}

__global__ __launch_bounds__(64) void k_sb_attn(const float* __restrict__ qh, const float* __restrict__ kh, const float* __restrict__ vh, float* __restrict__ mixo) {
    const int blk = blockIdx.x, qb = 63 - (blk / 48), bh = blk % 48;
    const int t = qb * 64 + threadIdx.x;
    const float* qp = qh + ((size_t)bh * S_ + t) * 64;
    float q[64], o[64];
#pragma unroll
    for (int d = 0; d < 64; ++d) { q[d] = qp[d] * 0.125f; o[d] = 0.f; }
    float carry = 0.f;
    const int smax = qb * 64 + 63;
    for (int s = smax - 1; s >= 0; --s) {
        const float* kp = kh + ((size_t)bh * S_ + s) * 64;
        const float* vp = vh + ((size_t)bh * S_ + s) * 64;
        float zz = 0.f;
#pragma unroll
        for (int d = 0; d < 64; ++d) zz += q[d] * kp[d];
        if (s < t) {
            const float sp = softplus_f(zz);
            const float w = expf(zz - sp - carry);
            carry += sp;
#pragma unroll
            for (int d = 0; d < 64; ++d) o[d] += w * vp[d];
        }
    }
    const int b = bh / 6, h = bh % 6;
    float* op = mixo + ((size_t)b * S_ + t) * D_ + h * 64;
#pragma unroll
    for (int d = 0; d < 64; ++d) op[d] = o[d];
}

__global__ __launch_bounds__(256) void k_ml_prep(const float* __restrict__ z, const float* __restrict__ cw, const float* __restrict__ cb,
                                                 const float* __restrict__ ib, const float* __restrict__ fb,
                                                 float* __restrict__ mq, float* __restrict__ mk, float* __restrict__ mv, float* __restrict__ gi, float* __restrict__ glf) {
    const int t = blockIdx.x, b = t / S_, s = t % S_, tid = threadIdx.x;
    for (int c = tid; c < 768; c += 256) {
        float acc = cb[c];
#pragma unroll
        for (int j = 0; j < 4; ++j) { const int sp = s - 3 + j; if (sp >= 0) acc += z[(size_t)(t - 3 + j) * INW + ZMQ + c] * cw[j * 768 + c]; }
        const float y = acc / (1.f + expf(-acc));
        const int cc = c % 384, h = cc / 64, d = cc % 64;
        const size_t o = (((size_t)b * 6 + h) * S_ + s) * 64 + d;
        if (c < 384) mq[o] = y; else mk[o] = y * 0.125f;
    }
    for (int c = tid; c < 384; c += 256) { const int h = c / 64, d = c % 64; mv[(((size_t)b * 6 + h) * S_ + s) * 64 + d] = z[(size_t)t * INW + ZMV + c]; }
    if (tid < 6) gi[((size_t)b * 6 + tid) * S_ + s] = z[(size_t)t * INW + ZMI + tid] + ib[tid];
    else if (tid < 12) { const int h = tid - 6; const float f = z[(size_t)t * INW + ZMF + h] + fb[h]; glf[((size_t)b * 6 + h) * S_ + s] = logsigmoid_f(f); }
}

constexpr int ML_LDS_FLOATS = 3 * 8192 + 4096 + 64 + 5 * 128;
__global__ __launch_bounds__(256) void k_ml_naive(const float* __restrict__ mq, const float* __restrict__ mk, const float* __restrict__ mv,
                                                  const float* __restrict__ gi, const float* __restrict__ glf, float* __restrict__ mixo) {
    extern __shared__ float sm[];
    float* sq = sm; float* sk = sq + 8192; float* sv = sk + 8192; float* sC = sv + 8192; float* sn = sC + 4096;
    float* sb = sn + 64; float* sa = sb + 128; float* sA = sa + 128; float* sws = sA + 128;
    const int bh = blockIdx.x, tid = threadIdx.x, b = bh / 6, h = bh % 6;
    for (int i = tid; i < 4096; i += 256) sC[i] = 0.f;
    if (tid < 64) sn[tid] = 0.f;
    float m_prev = 0.f;
    for (int c = 0; c < 32; ++c) {
        __syncthreads();
        const size_t base = ((size_t)bh * S_ + c * 128) * 64;
        for (int i = tid; i < 8192; i += 256) { sq[i] = mq[base + i]; sk[i] = mk[base + i]; sv[i] = mv[base + i]; }
        if (tid == 0) {
            float acc = 0.f, amax = -INFINITY;
            for (int s = 0; s < 128; ++s) {
                acc += glf[(size_t)bh * S_ + c * 128 + s]; sb[s] = acc;
                const float a = gi[(size_t)bh * S_ + c * 128 + s] - acc; sa[s] = a; amax = fmaxf(amax, a); sA[s] = amax;
            }
        }
        __syncthreads();
        {
            const int t = tid >> 1, half = tid & 1;
            const float Mt = fmaxf(m_prev, sA[t]);
            const float isc = expf(m_prev - Mt);
            float num[32]; float den = 0.f;
#pragma unroll
            for (int j = 0; j < 32; ++j) num[j] = 0.f;
            for (int s = 0; s <= t; ++s) {
                float qk = 0.f;
#pragma unroll 16
                for (int d = 0; d < 64; ++d) qk += sq[t * 64 + d] * sk[s * 64 + d];
                const float p = qk * expf(sa[s] - Mt);
                den += p;
#pragma unroll
                for (int j = 0; j < 32; ++j) num[j] += p * sv[s * 64 + half * 32 + j];
            }
            float qn = 0.f;
            for (int dk = 0; dk < 64; ++dk) {
                const float qv = sq[t * 64 + dk];
                qn += qv * sn[dk];
                const float qs = qv * isc;
#pragma unroll
                for (int j = 0; j < 32; ++j) num[j] += qs * sC[dk * 64 + half * 32 + j];
            }
            den += isc * qn;
            const float mt = sb[t] + Mt;
            const float dd = fmaxf(fabsf(den), expf(-mt));
            float* op = mixo + ((size_t)b * S_ + c * 128 + t) * D_ + 384 + h * 64 + half * 32;
#pragma unroll
            for (int j = 0; j < 32; ++j) op[j] = num[j] / dd;
        }
        __syncthreads();
        const float Ml = fmaxf(m_prev, sA[127]);
        const float decay = expf(m_prev - Ml);
        if (tid < 128) sws[tid] = expf(sa[tid] - Ml);
        __syncthreads();
#pragma unroll 1
        for (int e = 0; e < 16; ++e) {
            const int idx = tid + 256 * e, dk = idx >> 6, dv = idx & 63;
            float acc = decay * sC[idx];
            for (int s = 0; s < 128; ++s) acc += sws[s] * sk[s * 64 + dk] * sv[s * 64 + dv];
            sC[idx] = acc;
        }
        if (tid < 64) { float acc = decay * sn[tid]; for (int s = 0; s < 128; ++s) acc += sws[s] * sk[s * 64 + tid]; sn[tid] = acc; }
        m_prev = sb[127] + Ml;
    }
}

__global__ __launch_bounds__(256) void k_sg_prep(const float* __restrict__ z, const float* __restrict__ vng, float* __restrict__ su, float* __restrict__ sv) {
    const int t = blockIdx.x, c = threadIdx.x;
    const float u = gelu_tanh(z[(size_t)t * INW + ZSU + c]);
    const float v = gelu_tanh(z[(size_t)t * INW + ZSV + c]);
    const float ss = wave_sum(v * v);
    su[(size_t)t * 256 + c] = u;
    sv[(size_t)t * 256 + c] = v * rsqrtf(ss * (1.f / 64) + EPS) * vng[c];
}
__global__ __launch_bounds__(256) void k_sg(const float* __restrict__ su, const float* __restrict__ sv, const float* __restrict__ w, const float* __restrict__ bs, float* __restrict__ mixo) {
    const int t = blockIdx.x, c = threadIdx.x, g = c >> 6, tt = t & 127, base = t - tt;
    const float* wr = w + ((size_t)g * 128 + tt) * 128;
    float gate = bs[g * 128 + tt];
    for (int s = 0; s <= tt; ++s) gate += wr[s] * sv[(size_t)(base + s) * 256 + c];
    mixo[(size_t)t * D_ + 768 + c] = su[(size_t)t * 256 + c] * gate;
}

__global__ __launch_bounds__(256) void k_mix_norm(const float* __restrict__ mixo, const float* __restrict__ z, const float* __restrict__ og, float* __restrict__ y) {
    const int w = blockIdx.x * 4 + (threadIdx.x >> 6), lane = threadIdx.x & 63;
    const int t = w >> 4, hd = w & 15;
    const float v = mixo[(size_t)t * D_ + hd * 64 + lane];
    const float ss = wave_sum(v * v);
    float r = v * rsqrtf(ss * (1.f / 64) + EPS) * og[hd * 64 + lane];
    if (hd >= 6 && hd < 12) { const float o = z[(size_t)t * INW + ZMO + (hd - 6) * 64 + lane]; r *= 1.f / (1.f + expf(-o)); }
    y[(size_t)t * D_ + hd * 64 + lane] = r;
}

__device__ __forceinline__ void wave_argmax(float& v, int& p) {
#pragma unroll
    for (int o = 32; o > 0; o >>= 1) {
        const float ov = __shfl_xor(v, o, 64); const int op = __shfl_xor(p, o, 64);
        if (ov > v || (ov == v && op < p)) { v = ov; p = op; }
    }
}
__global__ __launch_bounds__(256) void k_peer_route(const float* __restrict__ pq, const float* __restrict__ keys, int* __restrict__ idx, float* __restrict__ gate) {
    __shared__ float s_q[4][256];
    __shared__ float s_sv[4][2][16];
    __shared__ int s_si[4][2][16];
    const int wv = threadIdx.x >> 6, lane = threadIdx.x & 63;
    const int w = blockIdx.x * 4 + wv, t = w >> 3, hd = w & 7;
    const float* qp = pq + (size_t)t * 2048 + hd * 256;
    for (int i = lane; i < 256; i += 64) s_q[wv][i] = qp[i];
    __syncthreads();
    for (int c = 0; c < 2; ++c) {
        const float* kb = keys + ((size_t)(hd * 2 + c) * 128) * 128;
        float v0 = 0.f, v1 = 0.f;
        const float* k0 = kb + (size_t)lane * 128; const float* k1 = kb + (size_t)(lane + 64) * 128;
        for (int d = 0; d < 128; ++d) { const float qv = s_q[wv][c * 128 + d]; v0 += qv * k0[d]; v1 += qv * k1[d]; }
        for (int r = 0; r < 16; ++r) {
            float bv; int bp;
            if (v0 >= v1) { bv = v0; bp = lane; } else { bv = v1; bp = lane + 64; }
            wave_argmax(bv, bp);
            if (bp == lane) v0 = -INFINITY;
            if (bp == lane + 64) v1 = -INFINITY;
            if (lane == 0) { s_sv[wv][c][r] = bv; s_si[wv][c][r] = bp; }
        }
    }
    __syncthreads();
    float cv[4];
#pragma unroll
    for (int e = 0; e < 4; ++e) { const int p = lane + 64 * e; cv[e] = s_sv[wv][0][p >> 4] + s_sv[wv][1][p & 15]; }
    float bs[16]; int bpv[16];
#pragma unroll
    for (int r = 0; r < 16; ++r) {
        float bv = cv[0]; int bp = lane;
#pragma unroll
        for (int e = 1; e < 4; ++e) if (cv[e] > bv) { bv = cv[e]; bp = lane + 64 * e; }
        wave_argmax(bv, bp);
#pragma unroll
        for (int e = 0; e < 4; ++e) if (bp == lane + 64 * e) cv[e] = -INFINITY;
        bs[r] = bv; bpv[r] = bp;
    }
    float sum = 0.f; const float bmax = bs[0];
#pragma unroll
    for (int r = 0; r < 16; ++r) { bs[r] = expf(bs[r] - bmax); sum += bs[r]; }
    const float inv = 1.f / sum;
#pragma unroll
    for (int r = 0; r < 16; ++r) if (lane == r) {
        const int p = bpv[r];
        idx[((size_t)t * 8 + hd) * 16 + r] = s_si[wv][0][p >> 4] * 128 + s_si[wv][1][p & 15];
        gate[((size_t)t * 8 + hd) * 16 + r] = bs[r] * inv;
    }
}

__global__ __launch_bounds__(256) void k_peer_expert(const float* __restrict__ xn, const int* __restrict__ idx, const float* __restrict__ gate,
                                                     const float* __restrict__ ut, const float* __restrict__ vt, float* x) {
    const int t = blockIdx.x * 4 + (threadIdx.x >> 6), lane = threadIdx.x & 63;
    const float4* xr = (const float4*)(xn + (size_t)t * D_);
    float4 xv[4], y[4];
#pragma unroll
    for (int i = 0; i < 4; ++i) { xv[i] = xr[lane + 64 * i]; y[i] = make_float4(0.f, 0.f, 0.f, 0.f); }
    for (int e = 0; e < 128; ++e) {
        const int id = idx[(size_t)t * 128 + e]; const float g = gate[(size_t)t * 128 + e];
        const float4* ur = (const float4*)(ut + (size_t)id * D_);
        const float4* vr = (const float4*)(vt + (size_t)id * D_);
        float acc = 0.f;
#pragma unroll
        for (int i = 0; i < 4; ++i) { const float4 u = ur[lane + 64 * i]; acc += u.x * xv[i].x + u.y * xv[i].y + u.z * xv[i].z + u.w * xv[i].w; }
        acc = wave_sum(acc);
        const float wgt = gelu_tanh(acc) * g;
#pragma unroll
        for (int i = 0; i < 4; ++i) { const float4 v = vr[lane + 64 * i]; y[i].x += wgt * v.x; y[i].y += wgt * v.y; y[i].z += wgt * v.z; y[i].w += wgt * v.w; }
    }
    float4* xo = (float4*)(x + (size_t)t * D_);
#pragma unroll
    for (int i = 0; i < 4; ++i) { float4 r = xo[lane + 64 * i]; r.x += y[i].x; r.y += y[i].y; r.z += y[i].z; r.w += y[i].w; xo[lane + 64 * i] = r; }
}

extern "C" void kernel_launch(void* const* d_in, const int* in_sizes, int n_in, void* d_out, int out_size, void* d_ws, size_t ws_size, hipStream_t stream) {
    const float* x_in = (const float*)d_in[0];
    const float* norm1_g = (const float*)d_in[1];
    const float* w_in = (const float*)d_in[2];
    const float* sb_qn_g = (const float*)d_in[3];
    const float* sb_kn_g = (const float*)d_in[4];
    const float* ml_conv_w = (const float*)d_in[5];
    const float* ml_conv_b = (const float*)d_in[6];
    const float* ml_i_b = (const float*)d_in[7];
    const float* ml_f_b = (const float*)d_in[8];
    const float* sg_vn_g = (const float*)d_in[9];
    const float* sg_w = (const float*)d_in[10];
    const float* sg_b = (const float*)d_in[11];
    const float* out_g = (const float*)d_in[12];
    const float* w_out = (const float*)d_in[13];
    const float* norm2_g = (const float*)d_in[14];
    const float* peer_wq = (const float*)d_in[15];
    const float* peer_keys = (const float*)d_in[16];
    const float* peer_u = (const float*)d_in[17];
    const float* peer_v = (const float*)d_in[18];
    float* xo = (float*)d_out;

    char* ws = (char*)d_ws;
    size_t off = 0;
    auto carve = [&](size_t bytes) { char* p = ws + off; off += (bytes + 255) & ~(size_t)255; return p; };
    float* zb = (float*)carve((size_t)T_ * INW * 4);
    float* pq = zb;
    float* bufA = (float*)carve((size_t)T_ * D_ * 4);
    float* qkv = (float*)carve((size_t)T_ * 1152 * 4);
    float* gi = (float*)carve((size_t)T_ * 6 * 4);
    float* glf = (float*)carve((size_t)T_ * 6 * 4);
    float* su = (float*)carve((size_t)T_ * 256 * 4);
    float* sv = (float*)carve((size_t)T_ * 256 * 4);
    float* mixo = (float*)carve((size_t)T_ * D_ * 4);
    int* idx = (int*)carve((size_t)T_ * 128 * 4);
    float* gate = (float*)carve((size_t)T_ * 128 * 4);
    float* q3 = qkv; float* k3 = qkv + (size_t)T_ * 384; float* v3 = qkv + (size_t)T_ * 768;

    static bool attr_set = false;
    if (!attr_set) { hipFuncSetAttribute((const void*)k_ml_naive, hipFuncAttributeMaxDynamicSharedMemorySize, ML_LDS_FLOATS * 4); attr_set = true; }

    for (int l = 0; l < DEPTH_; ++l) {
        const float* xcur = (l == 0) ? x_in : xo;
        k_rmsnorm<<<T_ / 4, 256, 0, stream>>>(xcur, norm1_g + (size_t)l * D_, bufA);
        k_gemm<false><<<dim3((INW + 63) / 64, T_ / 64), 256, 0, stream>>>(bufA, w_in + (size_t)l * D_ * INW, nullptr, zb, T_, INW, D_, INW, INW);
        k_sb_prep<<<T_ * 6 / 4, 256, 0, stream>>>(zb, sb_qn_g + l * 64, sb_kn_g + l * 64, q3, k3, v3);
        k_sb_attn<<<48 * 64, 64, 0, stream>>>(q3, k3, v3, mixo);
        k_ml_prep<<<T_, 256, 0, stream>>>(zb, ml_conv_w + (size_t)l * 4 * 768, ml_conv_b + l * 768, ml_i_b + l * 6, ml_f_b + l * 6, q3, k3, v3, gi, glf);
        k_ml_naive<<<48, 256, ML_LDS_FLOATS * 4, stream>>>(q3, k3, v3, gi, glf, mixo);
        k_sg_prep<<<T_, 256, 0, stream>>>(zb, sg_vn_g + l * 256, su, sv);
        k_sg<<<T_, 256, 0, stream>>>(su, sv, sg_w + (size_t)l * 4 * 128 * 128, sg_b + l * 4 * 128, mixo);
        k_mix_norm<<<T_ * 16 / 4, 256, 0, stream>>>(mixo, zb, out_g + (size_t)l * D_, bufA);
        k_gemm<true><<<dim3(D_ / 64, T_ / 64), 256, 0, stream>>>(bufA, w_out + (size_t)l * D_ * D_, xcur, xo, T_, D_, D_, D_, D_);
        k_rmsnorm<<<T_ / 4, 256, 0, stream>>>(xo, norm2_g + (size_t)l * D_, bufA);
        k_gemm<false><<<dim3(2048 / 64, T_ / 64), 256, 0, stream>>>(bufA, peer_wq + (size_t)l * D_ * 2048, nullptr, pq, T_, 2048, D_, 2048, 2048);
        k_peer_route<<<T_ * 8 / 4, 256, 0, stream>>>(pq, peer_keys + (size_t)l * 8 * 2 * 128 * 128, idx, gate);
        k_peer_expert<<<T_ / 4, 256, 0, stream>>>(bufA, idx, gate, peer_u + (size_t)l * 16384 * D_, peer_v + (size_t)l * 16384 * D_, xo);
    }
}
```

```cpp
#include <hip/hip_runtime.h>
#include <stdint.h>
#include <math.h>

constexpr int B_ = 8, S_ = 4096, D_ = 1024, T_ = B_ * S_, DEPTH_ = 4;
constexpr int INW = 3212;
constexpr int ZQ = 0, ZK = 384, ZV = 768, ZMQ = 1152, ZMV = 1920, ZMO = 2304, ZMI = 2688, ZMF = 2694, ZSU = 2700, ZSV = 2956;
constexpr float EPS = 1e-6f;

#define XB_TMO      128
#define XB_XCNT(j)  (256  + 64 * (j))
#define XB_XSUB(j)  (1280 + 64 * (j))
#define XB_XGEN(j)  (2304 + 64 * (j))
#define XB_TOP      3328
#define XB_TOPGEN   3392
#define XCD_BAR_WORDS 3456
#define XB_SPIN_CAP (1u << 21)
#define LAS __attribute__((address_space(3)))

__device__ __forceinline__ unsigned xb_ld(unsigned* p)              { return __hip_atomic_load(p, __ATOMIC_RELAXED, __HIP_MEMORY_SCOPE_AGENT); }
__device__ __forceinline__ unsigned xb_add(unsigned* p, unsigned v) { return __hip_atomic_fetch_add(p, v, __ATOMIC_RELAXED, __HIP_MEMORY_SCOPE_AGENT); }
__device__ __forceinline__ unsigned xb_xcc_id() { return (unsigned)__builtin_amdgcn_s_getreg((3 << 11) | 20) & 0xFu; }
#define XB_SPIN(cond, bar) do { unsigned _sp = 0; while (cond) { __builtin_amdgcn_s_sleep(1); \
    if ((++_sp & 255u) == 0u) { if (xb_ld(&(bar)[XB_TMO])) break; if (_sp > XB_SPIN_CAP) { atomicAdd(&(bar)[XB_TMO], 1u); break; } } } } while (0)

struct XcdBarrier {
    unsigned* bar; unsigned x;
    volatile LAS unsigned* st;
};

__device__ __forceinline__ XcdBarrier xcd_barrier_post(unsigned* bar, volatile LAS unsigned* st) {
    XcdBarrier b; b.bar = bar; b.x = xb_xcc_id(); b.st = st;
    if (threadIdx.x == 0) (void)xb_add(&bar[XB_XCNT(b.x)], 1u);
    return b;
}
__device__ __forceinline__ void xcd_barrier_complete(unsigned* bar, unsigned x, unsigned& nloc, unsigned& nx) {
    const unsigned G = gridDim.x * gridDim.y * gridDim.z;
    unsigned sum, cnt, mine, sp = 0u;
    for (;;) {
        sum = 0u; cnt = 0u; mine = 0u;
#pragma unroll
        for (unsigned j = 0; j < 16; ++j) { const unsigned c = xb_ld(&bar[XB_XCNT(j)]); sum += c; cnt += (c > 0u) ? 1u : 0u; mine = (j == x) ? c : mine; }
        if (sum == G) break;
        __builtin_amdgcn_s_sleep(1);
        if ((++sp & 255u) == 0u) { if (xb_ld(&bar[XB_TMO])) break; if (sp > XB_SPIN_CAP) { atomicAdd(&bar[XB_TMO], 1u); break; } }
    }
    nloc = mine > 0u ? mine : 1u; nx = cnt > 0u ? cnt : 1u;
}

__device__ __forceinline__ void xcd_barrier(const XcdBarrier& b) {
    asm volatile("s_waitcnt vmcnt(0)" ::: "memory");
    __syncthreads();
    if (threadIdx.x == 0) {
        unsigned* bar = b.bar;
        __builtin_amdgcn_s_waitcnt(0);
        unsigned nloc = b.st[0], nx = b.st[1];
        if (nloc == 0u) { xcd_barrier_complete(bar, b.x, nloc, nx); b.st[0] = nloc; b.st[1] = nx; }
        const unsigned old = xb_add(&bar[XB_XSUB(b.x)], 1u);
        const unsigned gen = old / nloc;
        if (old + 1u == (gen + 1u) * nloc) {
            __builtin_amdgcn_fence(__ATOMIC_RELEASE, "agent");
            asm volatile("s_waitcnt vmcnt(0)" ::: "memory");
            const unsigned og = xb_add(&bar[XB_TOP], 1u);
            const unsigned tg = og / nx;
            if (og + 1u == (tg + 1u) * nx) xb_add(&bar[XB_TOPGEN], 1u);
            else XB_SPIN(xb_ld(&bar[XB_TOPGEN]) == tg, bar);
            __builtin_amdgcn_fence(__ATOMIC_ACQUIRE, "agent");
            xb_add(&bar[XB_XGEN(b.x)], 1u);
            asm volatile("s_waitcnt vmcnt(0)" ::: "memory");
        } else {
            XB_SPIN(xb_ld(&bar[XB_XGEN(b.x)]) == gen, bar);
            __builtin_amdgcn_fence(__ATOMIC_ACQUIRE, "agent");
            asm volatile("s_waitcnt vmcnt(0)" ::: "memory");
        }
    }
    __syncthreads();
}


__device__ __forceinline__ int otid() { int t = threadIdx.x; asm volatile("" : "+v"(t)); return t; }
__device__ __forceinline__ float wave_sum(float v) {
#pragma unroll
    for (int o = 32; o > 0; o >>= 1) v += __shfl_xor(v, o, 64);
    return v;
}
__device__ __forceinline__ float gelu_tanh(float x) {
    const float u2 = 1.5957691216057308f * (x + 0.044715f * x * x * x);
    return x * __builtin_amdgcn_rcpf(1.f + __expf(-u2));
}
__device__ __forceinline__ float softplus_f(float z) { return fmaxf(z, 0.f) + log1pf(expf(-fabsf(z))); }
__device__ __forceinline__ float logsigmoid_f(float z) { return fminf(z, 0.f) - log1pf(expf(-fabsf(z))); }

typedef __attribute__((ext_vector_type(8))) short bf16x8;
typedef __attribute__((ext_vector_type(4))) short s16x4;
typedef __attribute__((ext_vector_type(16))) float f32x16;
typedef __attribute__((ext_vector_type(4))) unsigned u32x4;
typedef unsigned short bfu;
#define MFMA32(a, b, c) __builtin_amdgcn_mfma_f32_32x32x16_bf16((a), (b), (c), 0, 0, 0)
__device__ __forceinline__ unsigned pk2(float a, float b) {
    typedef __attribute__((ext_vector_type(2))) __bf16 bf2_t;
    typedef __attribute__((ext_vector_type(2))) float f2_t;
    f2_t v = {a, b};
    return __builtin_bit_cast(unsigned, __builtin_convertvector(v, bf2_t));
}
__device__ __forceinline__ bfu f2bf(float a) { return (bfu)(pk2(a, 0.f) & 0xffffu); }
__device__ __forceinline__ float bf2f(bfu b) { return __uint_as_float((unsigned)b << 16); }
__device__ __forceinline__ float bflo(unsigned u) { return __uint_as_float(u << 16); }
__device__ __forceinline__ float bfhi(unsigned u) { return __uint_as_float(u & 0xffff0000u); }
__device__ __forceinline__ int crow(int r, int hi) { return (r & 3) + 8 * (r >> 2) + 4 * hi; }
__device__ __forceinline__ size_t act_off(const size_t t, const int c) { return ((size_t)(c >> 5) * T_ + t) * 32 + (c & 31); }
constexpr float QSCALE_ = 0.125f * 1.4426950408889634f;
__device__ __forceinline__ void swap32(float x, float& lo, float& hi) {
    auto rr = __builtin_amdgcn_permlane32_swap(__float_as_uint(x), __float_as_uint(x), false, false);
    lo = __uint_as_float(rr[0]); hi = __uint_as_float(rr[1]);
}

template <bool REMAP>
__device__ __forceinline__ void d_transpose_w(const int vb, const float* __restrict__ w, bfu* __restrict__ wt, int ldw, int ntn, float* sm) {
    const int tn = vb % ntn, tk = vb / ntn, tid = otid();
    __syncthreads();
#pragma unroll
    for (int i = 0; i < 16; ++i) {
        const int k = i * 4 + (tid >> 6), n = tid & 63; int oc = tn * 64 + n; if (REMAP && oc >= 2688) oc += 12;
        sm[k * 65 + n] = w[(size_t)(tk * 64 + k) * ldw + oc];
    }
    __syncthreads();
#pragma unroll
    for (int i = 0; i < 16; ++i) {
        const int n = i * 4 + (tid >> 6), k = tid & 63;
        wt[((size_t)((tk * 64 + k) >> 5) * (ntn * 64) + tn * 64 + n) * 32 + (k & 31)] = f2bf(sm[k * 65 + n]);
    }
}

constexpr int GEMM_LDS = 73728;
struct UnitMap {
    int grp, NTT, NFT, tok_is_a;
    __device__ __forceinline__ void get(const int L, int& a0, int& b0) const {
        const int ttile = grp * NTT + (L / (8 * NFT)) * 8 + (L & 7), ftile = (L % (8 * NFT)) >> 3;
        if (tok_is_a) { a0 = ttile * 128; b0 = ftile * 256; } else { a0 = ftile * 128; b0 = ttile * 256; }
    }
};
struct OpLay { int rsA, ktsA, rsB, ktsB; };
template <class Epi>
__device__ __forceinline__ void gemm_stream(const bfu* __restrict__ Ag, const bfu* __restrict__ Bg, char* lds, const Epi& epi, const UnitMap um, const OpLay ol, const int L0, const int step) {
    constexpr int K = D_, KT = K / 32, STG = 24576;
    const int total = um.NTT * um.NFT;
    if (L0 >= total) return;
    const int tid = otid(), lane = tid & 63, wid = __builtin_amdgcn_readfirstlane(tid >> 6), wa = wid >> 1, wb = wid & 1, r = lane & 31, h = lane >> 5;
    const int srow = tid >> 2, sch = (tid & 3) ^ ((srow >> 2) & 3);
    const size_t lane_offA = (size_t)srow * ol.rsA + sch * 8, lane_offB = (size_t)srow * ol.rsB + sch * 8;
#define GDMA(AP, BP, kt, buf) { _Pragma("unroll") for (int j = 0; j < 2; ++j) \
        __builtin_amdgcn_global_load_lds((const unsigned*)((AP) + (size_t)(64 * j) * ol.rsA + (size_t)(kt) * ol.ktsA), (LAS unsigned*)(lds + (buf) * STG + j * 4096 + tid * 16), 16, 0, 0); \
    _Pragma("unroll") for (int j = 0; j < 4; ++j) \
        __builtin_amdgcn_global_load_lds((const unsigned*)((BP) + (size_t)(64 * j) * ol.rsB + (size_t)(kt) * ol.ktsB), (LAS unsigned*)(lds + (buf) * STG + 8192 + j * 4096 + tid * 16), 16, 0, 0); }
    int L = L0, a0, b0;
    um.get(L, a0, b0);
    const bfu* ap = Ag + (size_t)a0 * ol.rsA + lane_offA;
    const bfu* bp = Bg + (size_t)b0 * ol.rsB + lane_offB;
    __syncthreads();
    GDMA(ap, bp, 0, 0); GDMA(ap, bp, 1, 1);
    const int sw = (r >> 2) & 3;
    const int aoff = (wa * 64 + r) * 64, boff = 8192 + (wb * 128 + r) * 64;
    int cur = 0, nxt2 = 2;
    asm volatile("s_waitcnt vmcnt(0)" ::: "memory");
    __builtin_amdgcn_s_barrier();
#pragma unroll 1
    for (;;) {
        const int Ln = L + step; const bool has_next = Ln < total;
        int a0n = a0, b0n = b0; if (has_next) um.get(Ln, a0n, b0n);
        const bfu* apn = Ag + (size_t)a0n * ol.rsA + lane_offA;
        const bfu* bpn = Bg + (size_t)b0n * ol.rsB + lane_offB;
        f32x16 acc[2][4];
#pragma unroll
        for (int i = 0; i < 2; ++i)
#pragma unroll
            for (int j = 0; j < 4; ++j)
#pragma unroll
                for (int e = 0; e < 16; ++e) acc[i][j][e] = 0.f;
#pragma unroll 1
        for (int kt = 0; kt < KT; ++kt) {
            const char* lb = lds + cur * STG;
            bf16x8 af[2][2], bf[2][4];
            {
                const int co = ((0 * 2 + h) ^ sw) << 4;
#pragma unroll
                for (int i = 0; i < 2; ++i) af[0][i] = *(const bf16x8*)(lb + aoff + i * 2048 + co);
#pragma unroll
                for (int j = 0; j < 4; ++j) bf[0][j] = *(const bf16x8*)(lb + boff + j * 2048 + co);
            }
            __builtin_amdgcn_sched_barrier(0);
            {
                const int co = ((1 * 2 + h) ^ sw) << 4;
#pragma unroll
                for (int i = 0; i < 2; ++i) af[1][i] = *(const bf16x8*)(lb + aoff + i * 2048 + co);
#pragma unroll
                for (int j = 0; j < 4; ++j) bf[1][j] = *(const bf16x8*)(lb + boff + j * 2048 + co);
            }
            const bool in_unit = kt + 2 < KT;
            const bfu* apc = in_unit ? ap : apn; const bfu* bpc = in_unit ? bp : bpn;
            const int ktn = in_unit ? kt + 2 : (has_next ? kt + 2 - KT : KT - 1);
            GDMA(apc, bpc, ktn, nxt2);
#pragma unroll
            for (int ks = 0; ks < 2; ++ks)
#pragma unroll
                for (int i = 0; i < 2; ++i)
#pragma unroll
                    for (int j = 0; j < 4; ++j) acc[i][j] = MFMA32(af[ks][i], bf[ks][j], acc[i][j]);
#pragma unroll
            for (int g = 0; g < 6; ++g) { __builtin_amdgcn_sched_group_barrier(0x008, 1, 0); __builtin_amdgcn_sched_group_barrier(0x100, 1, 0); }
            __builtin_amdgcn_sched_group_barrier(0x008, 2, 0);
#pragma unroll
            for (int g = 0; g < 6; ++g) { __builtin_amdgcn_sched_group_barrier(0x010, 1, 0); __builtin_amdgcn_sched_group_barrier(0x008, 1, 0); }
            __builtin_amdgcn_sched_group_barrier(0x008, 2, 0);
            __builtin_amdgcn_sched_barrier(0);
            if (kt + 1 < KT) { asm volatile("s_waitcnt vmcnt(6)" ::: "memory"); __builtin_amdgcn_s_barrier(); }
            cur = (cur == 2) ? 0 : cur + 1; nxt2 = (nxt2 == 2) ? 0 : nxt2 + 1;
        }
        asm volatile("s_waitcnt vmcnt(0)" ::: "memory");
        __builtin_amdgcn_s_barrier();
        epi(acc, a0 + wa * 64, b0 + wb * 128, r, h, lds + nxt2 * STG, wa, wb);
        if (!has_next) break;
        L = Ln; a0 = a0n; b0 = b0n; ap = apn; bp = bpn;
    }
    asm volatile("s_waitcnt vmcnt(0)" ::: "memory");
#undef GDMA
}
template <bool RES, bool REMAP>
struct EpiF32 {
    const float* R; float* C; int ldc;
    __device__ __forceinline__ void operator()(f32x16 (&acc)[2][4], int abase, int bbase, int r, int h, char* xl, int wa, int wb) const {
#pragma unroll
        for (int i = 0; i < 2; ++i)
#pragma unroll
            for (int j = 0; j < 4; ++j) {
                int col = bbase + j * 32 + r; if (REMAP && col >= 2688) col += 12;
#pragma unroll
                for (int e = 0; e < 16; ++e) {
                    const size_t o = (size_t)(abase + i * 32 + crow(e, h)) * ldc + col;
                    C[o] = acc[i][j][e] + (RES ? R[o] : 0.f);
                }
            }
    }
};

template <bool GATES>
__device__ __forceinline__ void d_rmsnorm(const int vb, const float* __restrict__ x, const float* __restrict__ g, bfu* __restrict__ out,
                                          const float* swg, const float* __restrict__ ib, const float* __restrict__ fb, float* __restrict__ gi, float* __restrict__ glf) {
    const int row = vb * 4 + (otid() >> 6), lane = otid() & 63;
    const float4* xr = (const float4*)(x + (size_t)row * D_);
    const float4* g4 = (const float4*)g;
    float4 v[4]; float ss = 0.f;
#pragma unroll
    for (int i = 0; i < 4; ++i) { v[i] = xr[lane + 64 * i]; ss += v[i].x * v[i].x + v[i].y * v[i].y + v[i].z * v[i].z + v[i].w * v[i].w; }
    ss = wave_sum(ss);
    const float r = rsqrtf(ss * (1.f / D_) + EPS);
#pragma unroll
    for (int i = 0; i < 4; ++i) {
        const float4 gg = g4[lane + 64 * i];
        v[i].x *= r * gg.x; v[i].y *= r * gg.y; v[i].z *= r * gg.z; v[i].w *= r * gg.w;
        *(uint2*)(out + act_off(row, (lane + 64 * i) * 4)) = make_uint2(pk2(v[i].x, v[i].y), pk2(v[i].z, v[i].w));
    }
    if (GATES) {
        float mine = 0.f;
#pragma unroll
        for (int j = 0; j < 12; ++j) {
            float part = 0.f;
#pragma unroll
            for (int i = 0; i < 4; ++i) { const float4 w = *(const float4*)(swg + j * 1024 + (lane + 64 * i) * 4); part += v[i].x * w.x + v[i].y * w.y + v[i].z * w.z + v[i].w * w.w; }
            part = wave_sum(part);
            if (lane == j) mine = part;
        }
        const int b = row / S_, s = row % S_;
        if (lane < 6) gi[((size_t)b * 6 + lane) * S_ + s] = mine + ib[lane];
        else if (lane < 12) glf[((size_t)b * 6 + lane - 6) * S_ + s] = logsigmoid_f(mine + fb[lane - 6]);
    }
}
__device__ __forceinline__ void d_gatew(const int vb, const float* __restrict__ w_in, float* __restrict__ wg) {
    const int l = vb >> 2, k = (vb & 3) * 256 + otid();
    const float* src = w_in + ((size_t)l * D_ + k) * INW + ZMI;
    const float4 a = *(const float4*)src, b = *(const float4*)(src + 4), c = *(const float4*)(src + 8);
    const float v[12] = {a.x, a.y, a.z, a.w, b.x, b.y, b.z, b.w, c.x, c.y, c.z, c.w};
#pragma unroll
    for (int j = 0; j < 12; ++j) wg[((size_t)l * 12 + j) * 1024 + k] = v[j];
}

struct EpiBf16T {
    bfu* O; int ldo;
    __device__ __forceinline__ void operator()(f32x16 (&acc)[2][4], int abase, int bbase, int r, int h, char* xl, int wa, int wb) const {
#pragma unroll
        for (int j = 0; j < 4; ++j) {
            bfu* op = O + ((size_t)(abase >> 3) * T_ + (bbase + j * 32 + r)) * 8 + 4 * h;
#pragma unroll
            for (int i = 0; i < 2; ++i)
#pragma unroll
                for (int g = 0; g < 4; ++g)
                    *(uint2*)(op + (size_t)(4 * i + g) * T_ * 8) = make_uint2(pk2(acc[i][j][4 * g], acc[i][j][4 * g + 1]), pk2(acc[i][j][4 * g + 2], acc[i][j][4 * g + 3]));
        }
    }
};

struct EpiIn {
    const float* qg; const float* kg; const float* vng;
    bfu *sbq, *sbk, *sbv, *mlq, *mlk, *mlv, *mlo, *sgu, *sgv;
    __device__ __forceinline__ void operator()(f32x16 (&acc)[2][4], int abase, int bbase, int r, int h, char* xl, int wa, int wb) const {
        const int cb = __builtin_amdgcn_readfirstlane(abase >> 6);
#pragma unroll
        for (int j = 0; j < 4; ++j) {
            const int t = bbase + j * 32 + r, b = t >> 12, s = t & 4095;
            bfu* dst; float sc = 1.f; const float* gn = nullptr; size_t cst = (size_t)S_ * 8;
            if (cb < 6) { dst = sbq + (((size_t)b * 6 + cb) * 8 * S_ + s) * 8; gn = qg; sc = QSCALE_; }
            else if (cb < 12) { dst = sbk + (((size_t)b * 6 + cb - 6) * 8 * S_ + s) * 8; gn = kg; }
            else if (cb < 18) dst = sbv + (((size_t)b * 6 + cb - 12) * 8 * S_ + s) * 8;
            else if (cb < 24) dst = mlq + (((size_t)b * 6 + cb - 18) * 8 * S_ + s) * 8;
            else if (cb < 30) dst = mlk + (((size_t)b * 6 + cb - 24) * 8 * S_ + s) * 8;
            else if (cb < 36) dst = mlv + (((size_t)b * 6 + cb - 30) * 8 * S_ + s) * 8;
            else if (cb < 42) { dst = mlo + ((size_t)(cb - 36) * 8 * T_ + t) * 8; cst = (size_t)T_ * 8; }
            else if (cb < 46) { dst = sgu + ((size_t)(cb - 42) * 8 * T_ + t) * 8; cst = (size_t)T_ * 8; }
            else { dst = sgv + (((size_t)b * 4 + cb - 46) * 8 * S_ + s) * 8; gn = vng + (cb - 46) * 64; }
            if (cb >= 36 && cb < 42) {
#pragma unroll
                for (int i = 0; i < 2; ++i)
#pragma unroll
                    for (int e = 0; e < 16; ++e) acc[i][j][e] = __builtin_amdgcn_rcpf(1.f + __expf(-acc[i][j][e]));
            } else if (cb >= 42) {
#pragma unroll
                for (int i = 0; i < 2; ++i)
#pragma unroll
                    for (int e = 0; e < 16; ++e) acc[i][j][e] = gelu_tanh(acc[i][j][e]);
            }
            if (gn) {
                float ss = 0.f;
#pragma unroll
                for (int i = 0; i < 2; ++i)
#pragma unroll
                    for (int e = 0; e < 16; ++e) ss += acc[i][j][e] * acc[i][j][e];
                float lo, hi2; swap32(ss, lo, hi2);
                const float rinv = rsqrtf((lo + hi2) * (1.f / 64) + EPS) * sc;
#pragma unroll
                for (int i = 0; i < 2; ++i)
#pragma unroll
                    for (int g = 0; g < 4; ++g) {
                        const float4 g4 = *(const float4*)(gn + i * 32 + 8 * g + 4 * h);
                        acc[i][j][4 * g] *= rinv * g4.x; acc[i][j][4 * g + 1] *= rinv * g4.y; acc[i][j][4 * g + 2] *= rinv * g4.z; acc[i][j][4 * g + 3] *= rinv * g4.w;
                    }
            }
#pragma unroll
            for (int i = 0; i < 2; ++i)
#pragma unroll
                for (int g = 0; g < 4; ++g)
                    *(uint2*)(dst + (size_t)(4 * i + g) * cst + 4 * h) = make_uint2(pk2(acc[i][j][4 * g], acc[i][j][4 * g + 1]), pk2(acc[i][j][4 * g + 2], acc[i][j][4 * g + 3]));
        }
    }
};

__device__ __forceinline__ void d_cvt_bf16(const int vb, const float* __restrict__ src, bfu* __restrict__ dst) {
    const size_t e = (size_t)vb * 2048 + otid() * 8;
    const float4 a = *(const float4*)(src + e), b = *(const float4*)(src + e + 4);
    u32x4 o; o[0] = pk2(a.x, a.y); o[1] = pk2(a.z, a.w); o[2] = pk2(b.x, b.y); o[3] = pk2(b.z, b.w);
    *(u32x4*)(dst + e) = o;
}
typedef __attribute__((ext_vector_type(2))) __bf16 bf2_t;
__device__ __forceinline__ float dot2bf(unsigned a, unsigned b, float c) { return __builtin_amdgcn_fdot2_f32_bf16(__builtin_bit_cast(bf2_t, a), __builtin_bit_cast(bf2_t, b), c, false); }
__device__ __forceinline__ void d_peer_expert2(const int vb, const bfu* __restrict__ xn, const int* __restrict__ idx, const float* __restrict__ gate,
                                               const bfu* __restrict__ ut, const bfu* __restrict__ vt, float* x) {
    const int wv = __builtin_amdgcn_readfirstlane(otid() >> 6), lane = otid() & 63;
    const int t = vb * 4 + wv;
    const u32x4* xr = (const u32x4*)(xn + (size_t)t * D_);
    const u32x4 xp0 = xr[lane], xp1 = xr[lane + 64];
    float y[16];
#pragma unroll
    for (int i = 0; i < 16; ++i) y[i] = 0.f;
    const int* ip = idx + (size_t)t * 128; const float* gp = gate + (size_t)t * 128;
#pragma unroll 1
    for (int e0 = 0; e0 < 128; e0 += 8) {
        u32x4 u0[8], u1[8], v0[8], v1[8]; float a[8], g[8];
#pragma unroll
        for (int j = 0; j < 8; ++j) {
            const int id = ip[e0 + j]; g[j] = gp[e0 + j];
            const u32x4* ur = (const u32x4*)(ut + (size_t)id * D_); u0[j] = ur[lane]; u1[j] = ur[lane + 64];
            const u32x4* vr = (const u32x4*)(vt + (size_t)id * D_); v0[j] = vr[lane]; v1[j] = vr[lane + 64];
        }
#pragma unroll
        for (int j = 0; j < 8; ++j) {
            float acc = 0.f;
#pragma unroll
            for (int q = 0; q < 4; ++q) { acc = dot2bf(u0[j][q], xp0[q], acc); acc = dot2bf(u1[j][q], xp1[q], acc); }
            a[j] = acc;
        }
#pragma unroll
        for (int j = 0; j < 8; ++j) a[j] = wave_sum(a[j]);
#pragma unroll
        for (int j = 0; j < 8; ++j) {
            const float w = gelu_tanh(a[j]) * g[j];
#pragma unroll
            for (int q = 0; q < 4; ++q) {
                y[2 * q] += w * bflo(v0[j][q]); y[2 * q + 1] += w * bfhi(v0[j][q]);
                y[8 + 2 * q] += w * bflo(v1[j][q]); y[8 + 2 * q + 1] += w * bfhi(v1[j][q]);
            }
        }
    }
    float4* xo = (float4*)(x + (size_t)t * D_);
#pragma unroll
    for (int i = 0; i < 2; ++i) {
        float4 r0 = xo[lane * 2 + 128 * i], r1 = xo[lane * 2 + 128 * i + 1];
        r0.x += y[8 * i]; r0.y += y[8 * i + 1]; r0.z += y[8 * i + 2]; r0.w += y[8 * i + 3];
        r1.x += y[8 * i + 4]; r1.y += y[8 * i + 5]; r1.z += y[8 * i + 6]; r1.w += y[8 * i + 7];
        xo[lane * 2 + 128 * i] = r0; xo[lane * 2 + 128 * i + 1] = r1;
    }
}

__device__ __forceinline__ void d_cvt_fp8(const int vb, const float* __restrict__ src, unsigned char* __restrict__ dst, float* __restrict__ inv_scale) {
    const int tid = otid(), lane = tid & 63, row = vb * 4 + (tid >> 6);
    const float4* sr = (const float4*)(src + (size_t)row * D_);
    float4 v[4]; float am = 0.f;
#pragma unroll
    for (int i = 0; i < 4; ++i) { v[i] = sr[lane + 64 * i]; am = fmaxf(am, fmaxf(fmaxf(fabsf(v[i].x), fabsf(v[i].y)), fmaxf(fabsf(v[i].z), fabsf(v[i].w)))); }
#pragma unroll
    for (int o = 32; o > 0; o >>= 1) am = fmaxf(am, __shfl_xor(am, o, 64));
    const float sc = am > 0.f ? 256.f / am : 1.f;
    if (lane == 0) inv_scale[row] = am > 0.f ? am * (1.f / 256.f) : 1.f;
    unsigned* dr = (unsigned*)(dst + (size_t)row * D_);
#pragma unroll
    for (int i = 0; i < 4; ++i) {
        int w = 0;
        w = __builtin_amdgcn_cvt_pk_fp8_f32(v[i].x * sc, v[i].y * sc, w, false);
        w = __builtin_amdgcn_cvt_pk_fp8_f32(v[i].z * sc, v[i].w * sc, w, true);
        dr[lane + 64 * i] = (unsigned)w;
    }
}
typedef __attribute__((ext_vector_type(2))) float f2_t;
__device__ __forceinline__ void d_peer_expert3(const int vb, const bfu* __restrict__ xn, const int* __restrict__ idx, const float* __restrict__ gate,
                                               const unsigned char* __restrict__ ut, const unsigned char* __restrict__ vt, const float* __restrict__ usc, const float* __restrict__ vsc, float* x) {
    const int tid = otid(), lane = tid & 63;
    const int wv = __builtin_amdgcn_readfirstlane(tid >> 6);
    const int t = vb * 4 + wv;
    float xv[16], y[16];
    {
        const u32x4* xr = (const u32x4*)(xn + act_off(t, lane * 16));
        const u32x4 a = xr[0], b = xr[1];
#pragma unroll
        for (int q = 0; q < 4; ++q) { xv[2 * q] = bflo(a[q]); xv[2 * q + 1] = bfhi(a[q]); xv[8 + 2 * q] = bflo(b[q]); xv[8 + 2 * q + 1] = bfhi(b[q]); }
    }
#pragma unroll
    for (int i = 0; i < 16; ++i) y[i] = 0.f;
    const int* ip = idx + (size_t)t * 128; const float* gp = gate + (size_t)t * 128;
#pragma unroll 1
    for (int e0 = 0; e0 < 128; e0 += 16) {
        u32x4 u[16], v[16]; float a[16], g[16];
#pragma unroll
        for (int j = 0; j < 16; ++j) {
            const int id = ip[e0 + j];
            u[j] = *(const u32x4*)(ut + (size_t)id * D_ + lane * 16);
            v[j] = *(const u32x4*)(vt + (size_t)id * D_ + lane * 16);
            a[j] = usc[id]; g[j] = gp[e0 + j] * vsc[id];
        }
#pragma unroll
        for (int j = 0; j < 16; ++j) {
            float acc = 0.f;
#pragma unroll
            for (int q = 0; q < 4; ++q) {
                const f2_t lo = __builtin_amdgcn_cvt_pk_f32_fp8((int)u[j][q], false), hi = __builtin_amdgcn_cvt_pk_f32_fp8((int)u[j][q], true);
                acc += lo[0] * xv[4 * q] + lo[1] * xv[4 * q + 1] + hi[0] * xv[4 * q + 2] + hi[1] * xv[4 * q + 3];
            }
            a[j] *= wave_sum(acc);
        }
#pragma unroll
        for (int j = 0; j < 16; ++j) {
            const float w = gelu_tanh(a[j]) * g[j];
#pragma unroll
            for (int q = 0; q < 4; ++q) {
                const f2_t lo = __builtin_amdgcn_cvt_pk_f32_fp8((int)v[j][q], false), hi = __builtin_amdgcn_cvt_pk_f32_fp8((int)v[j][q], true);
                y[4 * q] += w * lo[0]; y[4 * q + 1] += w * lo[1]; y[4 * q + 2] += w * hi[0]; y[4 * q + 3] += w * hi[1];
            }
        }
    }
    float4* xo = (float4*)(x + (size_t)t * D_ + lane * 16);
#pragma unroll
    for (int i = 0; i < 4; ++i) { float4 r0 = xo[i]; r0.x += y[4 * i]; r0.y += y[4 * i + 1]; r0.z += y[4 * i + 2]; r0.w += y[4 * i + 3]; xo[i] = r0; }
}

template <int CTRL> __device__ __forceinline__ float dpp_f(float x) { return __int_as_float(__builtin_amdgcn_update_dpp(0, __float_as_int(x), CTRL, 0xF, 0xF, true)); }
__device__ __forceinline__ float row16_allreduce(float x) {
    x += dpp_f<0xB1>(x); x += dpp_f<0x4E>(x); x += dpp_f<0x124>(x); x += dpp_f<0x128>(x); return x;
}
__device__ __forceinline__ void d_peer_expert4(const int vb, const bfu* __restrict__ xn, const int* __restrict__ idx, const float* __restrict__ gate,
                                               const unsigned char* __restrict__ ut, const unsigned char* __restrict__ vt, const float* __restrict__ usc, const float* __restrict__ vsc, float* x) {
    const int tid = otid(), lane = tid & 63;
    const int wv = __builtin_amdgcn_readfirstlane(tid >> 6);
    const int t = vb * 4 + wv;
    float xv[16], y[16];
    {
        const u32x4* xr = (const u32x4*)(xn + act_off(t, lane * 16));
        const u32x4 a = xr[0], b = xr[1];
#pragma unroll
        for (int q = 0; q < 4; ++q) { xv[2 * q] = bflo(a[q]); xv[2 * q + 1] = bfhi(a[q]); xv[8 + 2 * q] = bflo(b[q]); xv[8 + 2 * q + 1] = bfhi(b[q]); }
    }
#pragma unroll
    for (int i = 0; i < 16; ++i) y[i] = 0.f;
    const int* ip = idx + (size_t)t * 128; const float* gp = gate + (size_t)t * 128;
    const int sel = (lane >> 2) & 3;
    const int el = ((lane >> 5) & 1) * 8 + ((lane >> 4) & 1) * 4 + sel;
#pragma unroll 1
    for (int e0 = 0; e0 < 128; e0 += 16) {
        u32x4 u[16], v[16];
#pragma unroll
        for (int j = 0; j < 16; ++j) {
            const int id = ip[e0 + j];
            u[j] = *(const u32x4*)(ut + (size_t)id * D_ + lane * 16);
            v[j] = *(const u32x4*)(vt + (size_t)id * D_ + lane * 16);
        }
        const int myid = ip[e0 + el];
        const float myus = usc[myid], mygs = gp[e0 + el] * vsc[myid];
        float pd[16];
#pragma unroll
        for (int j = 0; j < 16; ++j) {
            float acc = 0.f;
#pragma unroll
            for (int q = 0; q < 4; ++q) {
                const f2_t lo = __builtin_amdgcn_cvt_pk_f32_fp8((int)u[j][q], false), hi = __builtin_amdgcn_cvt_pk_f32_fp8((int)u[j][q], true);
                acc += lo[0] * xv[4 * q] + lo[1] * xv[4 * q + 1] + hi[0] * xv[4 * q + 2] + hi[1] * xv[4 * q + 3];
            }
            pd[j] = acc;
        }
        float q8[8], q4[4];
#pragma unroll
        for (int i = 0; i < 8; ++i) { auto rr = __builtin_amdgcn_permlane32_swap(__float_as_uint(pd[i]), __float_as_uint(pd[i + 8]), false, false); q8[i] = __uint_as_float(rr[0]) + __uint_as_float(rr[1]); }
#pragma unroll
        for (int i = 0; i < 4; ++i) { auto rr = __builtin_amdgcn_permlane16_swap(__float_as_uint(q8[i]), __float_as_uint(q8[i + 4]), false, false); q4[i] = row16_allreduce(__uint_as_float(rr[0]) + __uint_as_float(rr[1])); }
        const float s = sel == 0 ? q4[0] : sel == 1 ? q4[1] : sel == 2 ? q4[2] : q4[3];
        const float w = gelu_tanh(s * myus) * mygs;
#pragma unroll
        for (int j = 0; j < 16; ++j) {
            const float wj = __int_as_float(__builtin_amdgcn_readlane(__float_as_int(w), ((j >> 3) & 1) * 32 + ((j >> 2) & 1) * 16 + (j & 3) * 4));
#pragma unroll
            for (int q = 0; q < 4; ++q) {
                const f2_t lo = __builtin_amdgcn_cvt_pk_f32_fp8((int)v[j][q], false), hi = __builtin_amdgcn_cvt_pk_f32_fp8((int)v[j][q], true);
                y[4 * q] += wj * lo[0]; y[4 * q + 1] += wj * lo[1]; y[4 * q + 2] += wj * hi[0]; y[4 * q + 3] += wj * hi[1];
            }
        }
    }
    float4* xo = (float4*)(x + (size_t)t * D_ + lane * 16);
#pragma unroll
    for (int i = 0; i < 4; ++i) { float4 r0 = xo[i]; r0.x += y[4 * i]; r0.y += y[4 * i + 1]; r0.z += y[4 * i + 2]; r0.w += y[4 * i + 3]; xo[i] = r0; }
}

__device__ __forceinline__ void d_cvt_i4(const int vb, const float* __restrict__ src, unsigned char* __restrict__ dst  , float* __restrict__ step) {
    const int tid = otid(), lane = tid & 63, row = vb * 4 + (tid >> 6);
    const float4* sr = (const float4*)(src + (size_t)row * D_ + lane * 16);
    float v[16]; float am = 0.f, ss = 0.f;
#pragma unroll
    for (int i = 0; i < 4; ++i) { const float4 a = sr[i]; v[4 * i] = a.x; v[4 * i + 1] = a.y; v[4 * i + 2] = a.z; v[4 * i + 3] = a.w; }
#pragma unroll
    for (int i = 0; i < 16; ++i) { am = fmaxf(am, fabsf(v[i])); ss += v[i] * v[i]; }
    ss = wave_sum(ss);
#pragma unroll
    for (int o = 32; o > 0; o >>= 1) am = fmaxf(am, __shfl_xor(am, o, 64));
    float s = fmaxf(2.5f * sqrtf(ss * (1.f / D_)), am * (1.f / 16.f)) * (1.f / 7.f);
    if (!(s > 0.f)) s = 1.f;
    const float inv = 1.f / s;
    if (lane == 0) step[row] = s;
    unsigned w[2];
#pragma unroll
    for (int d = 0; d < 2; ++d) {
        unsigned acc = 0u;
#pragma unroll
        for (int e = 0; e < 8; ++e) {
            const int q = (int)fminf(fmaxf(rintf(v[8 * d + e] * inv), -8.f), 7.f);
            acc |= (unsigned)((e < 4) ? (q + 8) : (q & 15)) << ((e & 3) * 8 + (e >> 2) * 4);
        }
        w[d] = acc;
    }
    *(uint2*)(dst + (size_t)row * 1024 + lane * 16) = make_uint2(w[0], w[1]);
}
template <bool UENC>
__device__ __forceinline__ void d_cvt_i4x2(const int vb, const float* __restrict__ src, unsigned char* __restrict__ dst, float* __restrict__ step) {
    const int tid = otid(), lane = tid & 63, row0 = vb * 8 + (tid >> 6) * 2;
    float v[2][16];
#pragma unroll
    for (int rr = 0; rr < 2; ++rr) {
        const float4* sr = (const float4*)(src + (size_t)(row0 + rr) * D_ + lane * 16);
#pragma unroll
        for (int i = 0; i < 4; ++i) { const float4 a = sr[i]; v[rr][4 * i] = a.x; v[rr][4 * i + 1] = a.y; v[rr][4 * i + 2] = a.z; v[rr][4 * i + 3] = a.w; }
    }
#pragma unroll
    for (int rr = 0; rr < 2; ++rr) {
        float am = 0.f, ss = 0.f;
#pragma unroll
        for (int i = 0; i < 16; ++i) { am = fmaxf(am, fabsf(v[rr][i])); ss += v[rr][i] * v[rr][i]; }
        ss = wave_sum(ss);
#pragma unroll
        for (int o = 32; o > 0; o >>= 1) am = fmaxf(am, __shfl_xor(am, o, 64));
        float s = fmaxf(2.5f * sqrtf(ss * (1.f / D_)), am * (1.f / 16.f)) * (1.f / 7.f);
        if (!(s > 0.f)) s = 1.f;
        const float inv = 1.f / s;
        if (lane == 0) step[row0 + rr] = s;
        unsigned w[2];
#pragma unroll
        for (int d = 0; d < 2; ++d) {
            unsigned acc = 0u;
#pragma unroll
            for (int e = 0; e < 8; ++e) {
                const int q = (int)fminf(fmaxf(rintf(v[rr][8 * d + e] * inv), -8.f), 7.f);
                if (UENC) acc |= (unsigned)(q & 15) << (4 * e);
                else acc |= (unsigned)((e < 4) ? (q + 8) : (q & 15)) << ((e & 3) * 8 + (e >> 2) * 4);
            }
            w[d] = acc;
        }
        *(uint2*)(dst + (size_t)(row0 + rr) * 1024 + lane * 16) = make_uint2(w[0], w[1]);
    }
}
__device__ __forceinline__ float ub0(unsigned w) { float r; asm("v_cvt_f32_ubyte0 %0, %1" : "=v"(r) : "v"(w)); return r; }
__device__ __forceinline__ float ub1(unsigned w) { float r; asm("v_cvt_f32_ubyte1 %0, %1" : "=v"(r) : "v"(w)); return r; }
__device__ __forceinline__ float ub2(unsigned w) { float r; asm("v_cvt_f32_ubyte2 %0, %1" : "=v"(r) : "v"(w)); return r; }
__device__ __forceinline__ float ub3(unsigned w) { float r; asm("v_cvt_f32_ubyte3 %0, %1" : "=v"(r) : "v"(w)); return r; }
template <int CTRL> __device__ __forceinline__ int dpp_i(int x) { return __builtin_amdgcn_update_dpp(0, x, CTRL, 0xF, 0xF, true); }
__device__ __forceinline__ int transpose_reduce16(const int (&pd)[16], const int sel) {
    int q8[8], q4[4];
#pragma unroll
    for (int i = 0; i < 8; ++i) { auto rr = __builtin_amdgcn_permlane32_swap((unsigned)pd[i], (unsigned)pd[i + 8], false, false); q8[i] = (int)rr[0] + (int)rr[1]; }
#pragma unroll
    for (int i = 0; i < 4; ++i) {
        auto rr = __builtin_amdgcn_permlane16_swap((unsigned)q8[i], (unsigned)q8[i + 4], false, false);
        int x = (int)rr[0] + (int)rr[1];
        x += dpp_i<0xB1>(x); x += dpp_i<0x4E>(x); x += dpp_i<0x124>(x); x += dpp_i<0x128>(x);
        q4[i] = x;
    }
    return sel == 0 ? q4[0] : sel == 1 ? q4[1] : sel == 2 ? q4[2] : q4[3];
}
template <bool FUSE_NORM>
__device__ __forceinline__ void d_peer_expert5(const int vb, bfu* xn, const int* __restrict__ idx, const float* __restrict__ gate,
                                               const unsigned char* __restrict__ ut, const unsigned char* __restrict__ vt, const float* __restrict__ usc, const float* __restrict__ vsc, float* x,
                                               const float* __restrict__ g1n, const float* swg, const float* __restrict__ ib, const float* __restrict__ fb, float* __restrict__ gi, float* __restrict__ glf) {
    const int tid = otid(), lane = tid & 63;
    const int wv = __builtin_amdgcn_readfirstlane(tid >> 6);
    const int t = vb * 4 + wv;
    int xh[2], xl[2]; float xs;
    {
        float xv[16];
        const u32x4* xr = (const u32x4*)(xn + act_off(t, lane * 16));
        const u32x4 a = xr[0], b = xr[1];
#pragma unroll
        for (int q = 0; q < 4; ++q) { xv[2 * q] = bflo(a[q]); xv[2 * q + 1] = bfhi(a[q]); xv[8 + 2 * q] = bflo(b[q]); xv[8 + 2 * q + 1] = bfhi(b[q]); }
        float am = 0.f;
#pragma unroll
        for (int i = 0; i < 16; ++i) am = fmaxf(am, fabsf(xv[i]));
#pragma unroll
        for (int o = 32; o > 0; o >>= 1) am = fmaxf(am, __shfl_xor(am, o, 64));
        xs = am > 0.f ? am * (1.f / 119.f) : 1.f;
        const float inv = 1.f / xs;
#pragma unroll
        for (int d = 0; d < 2; ++d) {
            unsigned ah = 0u, al = 0u;
#pragma unroll
            for (int e = 0; e < 8; ++e) {
                const int q = (int)rintf(xv[8 * d + e] * inv);
                const int lo4 = ((q + 8) & 15) - 8, hi4 = (q - lo4) >> 4;
                ah |= (unsigned)(hi4 & 15) << (4 * e); al |= (unsigned)(lo4 & 15) << (4 * e);
            }
            xh[d] = (int)ah; xl[d] = (int)al;
        }
    }
    float y[16];
#pragma unroll
    for (int i = 0; i < 16; ++i) y[i] = 0.f;
    const int* ip = idx + (size_t)t * 128; const float* gp = gate + (size_t)t * 128;
    const int sel = (lane >> 2) & 3;
    const int el = ((lane >> 5) & 1) * 8 + ((lane >> 4) & 1) * 4 + sel;
#pragma unroll 1
    for (int e0 = 0; e0 < 128; e0 += 32) {
        uint2 u[32], v[32];
#pragma unroll
        for (int j = 0; j < 32; ++j) {
            const int id = ip[e0 + j];
            const u32x4 uv = *(const u32x4*)(ut + (size_t)id * 1024 + lane * 16);
            u[j] = make_uint2(uv[0], uv[1]); v[j] = make_uint2(uv[2], uv[3]);
        }
        const int myid0 = ip[e0 + el], myid1 = ip[e0 + 16 + el];
        const float us0 = usc[myid0] * xs, us1 = usc[myid1] * xs, gs0 = gp[e0 + el] * vsc[myid0], gs1 = gp[e0 + 16 + el] * vsc[myid1];
        float w0, w1;
        {
            int pd[16];
#pragma unroll
            for (int j = 0; j < 16; ++j) {
                int acch = __builtin_amdgcn_sdot8((int)u[j].x, xh[0], 0, false);
                acch = __builtin_amdgcn_sdot8((int)u[j].y, xh[1], acch, false);
                int accl = __builtin_amdgcn_sdot8((int)u[j].x, xl[0], 0, false);
                accl = __builtin_amdgcn_sdot8((int)u[j].y, xl[1], accl, false);
                pd[j] = (acch << 4) + accl;
            }
            w0 = gelu_tanh((float)transpose_reduce16(pd, sel) * us0) * gs0;
#pragma unroll
            for (int j = 0; j < 16; ++j) {
                int acch = __builtin_amdgcn_sdot8((int)u[16 + j].x, xh[0], 0, false);
                acch = __builtin_amdgcn_sdot8((int)u[16 + j].y, xh[1], acch, false);
                int accl = __builtin_amdgcn_sdot8((int)u[16 + j].x, xl[0], 0, false);
                accl = __builtin_amdgcn_sdot8((int)u[16 + j].y, xl[1], accl, false);
                pd[j] = (acch << 4) + accl;
            }
            w1 = gelu_tanh((float)transpose_reduce16(pd, sel) * us1) * gs1;
        }
        float wam = fmaxf(fabsf(w0), fabsf(w1));
#pragma unroll
        for (int o = 32; o > 0; o >>= 1) wam = fmaxf(wam, __shfl_xor(wam, o, 64));
        const float wsc = wam > 0.f ? wam * (1.f / 127.f) : 1.f, winv = 1.f / wsc;
        const int wq0 = (int)rintf(w0 * winv), wq1 = (int)rintf(w1 * winv);
        unsigned wpk[8]; int swq = 0;
#pragma unroll
        for (int g = 0; g < 8; ++g) {
            int bq[4];
#pragma unroll
            for (int i = 0; i < 4; ++i) {
                const int j = 4 * g + i, jj = j & 15;
                bq[i] = __builtin_amdgcn_readlane(j < 16 ? wq0 : wq1, ((jj >> 3) & 1) * 32 + ((jj >> 2) & 1) * 16 + (jj & 3) * 4);
                swq += bq[i];
            }
            wpk[g] = (unsigned)(bq[0] & 255) | ((unsigned)(bq[1] & 255) << 8) | ((unsigned)(bq[2] & 255) << 16) | ((unsigned)bq[3] << 24);
        }
        int a1[8], a2[8];
#pragma unroll
        for (int e = 0; e < 8; ++e) { a1[e] = -8 * swq; a2[e] = 0; }
#pragma unroll
        for (int g = 0; g < 8; ++g) {
#pragma unroll
            for (int s = 0; s < 2; ++s) {
                unsigned q[4];
#pragma unroll
                for (int i = 0; i < 4; ++i) q[i] = s ? v[4 * g + i].y : v[4 * g + i].x;
                const unsigned p0 = __builtin_amdgcn_perm(q[1], q[0], 0x05010400u), p1 = __builtin_amdgcn_perm(q[1], q[0], 0x07030602u);
                const unsigned p2 = __builtin_amdgcn_perm(q[3], q[2], 0x05010400u), p3 = __builtin_amdgcn_perm(q[3], q[2], 0x07030602u);
                const unsigned t0 = __builtin_amdgcn_perm(p2, p0, 0x05040100u), t1 = __builtin_amdgcn_perm(p2, p0, 0x07060302u);
                const unsigned t2 = __builtin_amdgcn_perm(p3, p1, 0x05040100u), t3 = __builtin_amdgcn_perm(p3, p1, 0x07060302u);
                a1[4 * s] = __builtin_amdgcn_sdot4((int)t0, (int)wpk[g], a1[4 * s], false);
                a1[4 * s + 1] = __builtin_amdgcn_sdot4((int)t1, (int)wpk[g], a1[4 * s + 1], false);
                a1[4 * s + 2] = __builtin_amdgcn_sdot4((int)t2, (int)wpk[g], a1[4 * s + 2], false);
                a1[4 * s + 3] = __builtin_amdgcn_sdot4((int)t3, (int)wpk[g], a1[4 * s + 3], false);
                a2[4 * s] = __builtin_amdgcn_sdot4((int)(t0 & 0xF0F0F0F0u), (int)wpk[g], a2[4 * s], false);
                a2[4 * s + 1] = __builtin_amdgcn_sdot4((int)(t1 & 0xF0F0F0F0u), (int)wpk[g], a2[4 * s + 1], false);
                a2[4 * s + 2] = __builtin_amdgcn_sdot4((int)(t2 & 0xF0F0F0F0u), (int)wpk[g], a2[4 * s + 2], false);
                a2[4 * s + 3] = __builtin_amdgcn_sdot4((int)(t3 & 0xF0F0F0F0u), (int)wpk[g], a2[4 * s + 3], false);
            }
        }
        int yi[16];
#pragma unroll
        for (int s = 0; s < 2; ++s)
#pragma unroll
            for (int e = 0; e < 4; ++e) { yi[8 * s + e] = a1[4 * s + e] - a2[4 * s + e]; yi[8 * s + e + 4] = a2[4 * s + e] >> 4; }
#pragma unroll
        for (int e = 0; e < 16; ++e) y[e] += wsc * (float)yi[e];
    }
    float4* xo = (float4*)(x + (size_t)t * D_ + lane * 16);
    float ss = 0.f;
#pragma unroll
    for (int i = 0; i < 4; ++i) {
        float4 r0 = xo[i]; r0.x += y[4 * i]; r0.y += y[4 * i + 1]; r0.z += y[4 * i + 2]; r0.w += y[4 * i + 3]; xo[i] = r0;
        y[4 * i] = r0.x; y[4 * i + 1] = r0.y; y[4 * i + 2] = r0.z; y[4 * i + 3] = r0.w;
        ss += r0.x * r0.x + r0.y * r0.y + r0.z * r0.z + r0.w * r0.w;
    }
    if (FUSE_NORM) {
        ss = wave_sum(ss);
        const float rn = rsqrtf(ss * (1.f / D_) + EPS);
#pragma unroll
        for (int i = 0; i < 4; ++i) { const float4 gg = *(const float4*)(g1n + lane * 16 + 4 * i); y[4 * i] *= rn * gg.x; y[4 * i + 1] *= rn * gg.y; y[4 * i + 2] *= rn * gg.z; y[4 * i + 3] *= rn * gg.w; }
        u32x4 o0, o1;
#pragma unroll
        for (int i = 0; i < 4; ++i) { o0[i] = pk2(y[2 * i], y[2 * i + 1]); o1[i] = pk2(y[8 + 2 * i], y[8 + 2 * i + 1]); }
        u32x4* xw = (u32x4*)(xn + act_off(t, lane * 16));
        xw[0] = o0; xw[1] = o1;
        float mine = 0.f;
#pragma unroll
        for (int j = 0; j < 12; ++j) {
            float part = 0.f;
#pragma unroll
            for (int i = 0; i < 4; ++i) { const float4 w4 = *(const float4*)(swg + j * 1024 + lane * 16 + 4 * i); part += y[4 * i] * w4.x + y[4 * i + 1] * w4.y + y[4 * i + 2] * w4.z + y[4 * i + 3] * w4.w; }
            part = wave_sum(part);
            if (lane == j) mine = part;
        }
        const int b = t / S_, s = t % S_;
        if (lane < 6) gi[((size_t)b * 6 + lane) * S_ + s] = mine + ib[lane];
        else if (lane < 12) glf[((size_t)b * 6 + lane - 6) * S_ + s] = logsigmoid_f(mine + fb[lane - 6]);
    }
}

typedef short v4i16_t __attribute__((ext_vector_type(4)));
__device__ __forceinline__ s16x4 vtr(const char* p) { return __builtin_bit_cast(s16x4, __builtin_amdgcn_ds_read_tr16_b64_v4i16((LAS v4i16_t*)p)); }
__device__ __forceinline__ void sb_subtile(const f32x16& p, const int keybase, const int qg, const bool diag, const int h, float& carry, bf16x8& f0, bf16x8& f1) {
    float bt[16], rr[16];
#pragma unroll
    for (int e = 0; e < 16; ++e) {
        float pe = fminf(p[e], 120.f);
        if (diag) { const int key = keybase + (e & 3) + 8 * (e >> 2); if (key >= qg) pe = -INFINITY; }
        const float t = __builtin_amdgcn_exp2f(pe);
        const float r = __builtin_amdgcn_rcpf(1.f + t);
        bt[e] = t * r; rr[e] = r;
    }
    float lo[4], hi[4];
#pragma unroll
    for (int g = 0; g < 4; ++g) swap32((rr[4 * g] * rr[4 * g + 1]) * (rr[4 * g + 2] * rr[4 * g + 3]), lo[g], hi[g]);
    float T[8];
    T[7] = 1.f; T[6] = hi[3]; T[5] = T[6] * lo[3]; T[4] = T[5] * hi[2]; T[3] = T[4] * lo[2]; T[2] = T[3] * hi[1]; T[1] = T[2] * lo[1]; T[0] = T[1] * hi[0];
    const float total = T[0] * lo[0];
    float w[16];
#pragma unroll
    for (int g = 0; g < 4; ++g) {
        float c = carry * (h ? T[2 * g + 1] : T[2 * g]);
#pragma unroll
        for (int i = 3; i >= 0; --i) {
            const int e = 4 * g + i;
            w[e] = bt[e] * c;
            c *= rr[e];
        }
    }
    carry *= total;
    u32x4 a, b;
#pragma unroll
    for (int i = 0; i < 4; ++i) { a[i] = pk2(w[2 * i], w[2 * i + 1]); b[i] = pk2(w[8 + 2 * i], w[8 + 2 * i + 1]); }
    f0 = __builtin_bit_cast(bf16x8, a); f1 = __builtin_bit_cast(bf16x8, b);
}
constexpr int SBA_LDS = 32768;
__device__ __forceinline__ void d_sb_attn2(const int unit, const bfu* __restrict__ Qs, const bfu* __restrict__ Ks, const bfu* __restrict__ Vs,
                                           const float* __restrict__ og, bfu* __restrict__ y, char* lds) {
    const int qb = 31 - unit / 48, bh = unit % 48, b = bh / 6, hh = bh % 6;
    const int tid = otid(), lane = tid & 63, r = lane & 31, h = lane >> 5;
    const int wid = __builtin_amdgcn_readfirstlane(tid >> 6);
    const bfu* Kg = Ks + (size_t)bh * S_ * 64; const bfu* Vg = Vs + (size_t)bh * S_ * 64;
    const int q0 = qb * 128 + wid * 32, qg = q0 + r;
    bf16x8 qf[4];
#pragma unroll
    for (int ks = 0; ks < 4; ++ks) qf[ks] = *(const bf16x8*)(Qs + (size_t)bh * S_ * 64 + ((size_t)(2 * ks + h) * S_ + qg) * 8);
    f32x16 o0, o1;
#pragma unroll
    for (int e = 0; e < 16; ++e) { o0[e] = 0.f; o1[e] = 0.f; }
    float carry = 1.f;
    const int nt = 2 * qb + 2;
    const int srow = tid >> 3, sch = tid & 7;
    const int koff = srow * 128 + ((sch ^ (srow & 7)) << 4), voff = 8192 + (sch >> 2) * 4096 + srow * 64 + (sch & 3) * 16;
    u32x4 sk0, sk1, sv0, sv1;
#define GLOAD(kt) { const size_t gb = ((size_t)sch * S_ + (kt) * 64 + srow) * 8; sk0 = *(const u32x4*)(Kg + gb); sk1 = *(const u32x4*)(Kg + gb + 256); sv0 = *(const u32x4*)(Vg + gb); sv1 = *(const u32x4*)(Vg + gb + 256); }
#define LSTORE(buf) { char* bb = lds + (buf) * 16384; *(u32x4*)(bb + koff) = sk0; *(u32x4*)(bb + koff + 4096) = sk1; *(u32x4*)(bb + voff) = sv0; *(u32x4*)(bb + voff + 2048) = sv1; }
    __syncthreads();
    GLOAD(nt - 1); LSTORE(0);
    __syncthreads();
    const int kro = r * 128, sw = r & 7;
    volatile int* sflag = (volatile int*)(lds + SBA_LDS);
    const int vlane = 8192 + ((lane >> 4) & 1) * 32 + (lane & 3) * 8 + (4 * h + ((lane & 15) >> 2)) * 64;
#pragma unroll 1
    for (int it = 0; it < nt; ++it) {
        const int kt = nt - 1 - it;
        if (it + 1 < nt) GLOAD(kt - 1);
        const char* kb_ = lds + (it & 1) * 16384;
        f32x16 p0, p1;
#pragma unroll
        for (int e = 0; e < 16; ++e) { p0[e] = 0.f; p1[e] = 0.f; }
#pragma unroll
        for (int ks = 0; ks < 4; ++ks) {
            const int co = ((2 * ks + h) ^ sw) << 4;
            const bf16x8 k0 = *(const bf16x8*)(kb_ + kro + co), k1 = *(const bf16x8*)(kb_ + kro + 4096 + co);
            p0 = MFMA32(k0, qf[ks], p0); p1 = MFMA32(k1, qf[ks], p1);
        }
        const bool diag = kt >= 2 * qb;
        bf16x8 pf[4];
        sb_subtile(p1, kt * 64 + 32 + 4 * h, qg, diag, h, carry, pf[2], pf[3]);
        sb_subtile(p0, kt * 64 + 4 * h, qg, diag, h, carry, pf[0], pf[1]);
#pragma unroll
        for (int kk = 0; kk < 4; ++kk) {
            const char* vp = kb_ + vlane + kk * 1024;
            const s16x4 a0 = vtr(vp), a1 = vtr(vp + 512), b0 = vtr(vp + 4096), b1 = vtr(vp + 4096 + 512);
            const bf16x8 v0 = __builtin_shufflevector(a0, a1, 0, 1, 2, 3, 4, 5, 6, 7), v1 = __builtin_shufflevector(b0, b1, 0, 1, 2, 3, 4, 5, 6, 7);
            o0 = MFMA32(v0, pf[kk], o0); o1 = MFMA32(v1, pf[kk], o1);
        }
        if (it + 1 < nt) LSTORE((it + 1) & 1);
        const int alldone = __all(carry < 0x1p-120f) ? 1 : 0;
        if (lane == 0) sflag[(it & 1) * 4 + wid] = alldone;
        __syncthreads();
        if ((sflag[(it & 1) * 4] & sflag[(it & 1) * 4 + 1] & sflag[(it & 1) * 4 + 2] & sflag[(it & 1) * 4 + 3]) != 0) break;
    }
#undef GLOAD
#undef LSTORE
    float ss = 0.f;
#pragma unroll
    for (int e = 0; e < 16; ++e) ss += o0[e] * o0[e] + o1[e] * o1[e];
    float slo, shi; swap32(ss, slo, shi);
    const float rinv = rsqrtf((slo + shi) * (1.f / 64) + EPS);
    bfu* yp = y + act_off((size_t)b * S_ + qg, hh * 64) + 4 * h;
    const float* gp = og + hh * 64 + 4 * h;
#pragma unroll
    for (int g = 0; g < 4; ++g) {
        const float4 g0 = *(const float4*)(gp + 8 * g), g1 = *(const float4*)(gp + 32 + 8 * g);
        *(uint2*)(yp + 8 * g) = make_uint2(pk2(o0[4 * g] * rinv * g0.x, o0[4 * g + 1] * rinv * g0.y), pk2(o0[4 * g + 2] * rinv * g0.z, o0[4 * g + 3] * rinv * g0.w));
        *(uint2*)(yp + (size_t)T_ * 32 + 8 * g) = make_uint2(pk2(o1[4 * g] * rinv * g1.x, o1[4 * g + 1] * rinv * g1.y), pk2(o1[4 * g + 2] * rinv * g1.z, o1[4 * g + 3] * rinv * g1.w));
    }
}

__device__ __forceinline__ void d_cvt_sgw(const int vb, const float* __restrict__ src, bfu* __restrict__ dst) {
    const size_t e = (size_t)vb * 2048 + otid() * 8;
    const int s0 = (int)(e & 127), t = (int)((e >> 7) & 127);
    const float4 a = *(const float4*)(src + e), b = *(const float4*)(src + e + 4);
    const float v[8] = {a.x, a.y, a.z, a.w, b.x, b.y, b.z, b.w};
    u32x4 o;
#pragma unroll
    for (int i = 0; i < 4; ++i) o[i] = pk2(s0 + 2 * i <= t ? v[2 * i] : 0.f, s0 + 2 * i + 1 <= t ? v[2 * i + 1] : 0.f);
    *(u32x4*)(dst + e) = o;
}

__device__ __forceinline__ float silu_f(float x) { return x * __builtin_amdgcn_rcpf(1.f + __expf(-x)); }
__device__ __forceinline__ void ml_scan(const float* __restrict__ gi, const float* __restrict__ glf, const int lane, float* s_b, float* s_a, float* s_A, float& b_last, float& A_last) {
    const float2 f = *(const float2*)(glf + 2 * lane), iv = *(const float2*)(gi + 2 * lane);
    float x = f.x + f.y;
#pragma unroll
    for (int o = 1; o < 64; o <<= 1) { const float t = __shfl_up(x, o, 64); if (lane >= o) x += t; }
    const float b1 = x, b0 = x - f.y;
    const float a0 = iv.x - b0, a1 = iv.y - b1;
    float m = fmaxf(a0, a1);
#pragma unroll
    for (int o = 1; o < 64; o <<= 1) { const float t = __shfl_up(m, o, 64); if (lane >= o) m = fmaxf(m, t); }
    float prev = __shfl_up(m, 1, 64); if (lane == 0) prev = -INFINITY;
    *(float2*)(s_b + 2 * lane) = make_float2(b0, b1);
    *(float2*)(s_a + 2 * lane) = make_float2(a0, a1);
    *(float2*)(s_A + 2 * lane) = make_float2(fmaxf(prev, a0), m);
    b_last = __shfl(b1, 63, 64); A_last = __shfl(m, 63, 64);
}
__device__ __forceinline__ void conv8(const bfu* __restrict__ raw, const int sg, const int ch, const float* __restrict__ cw, const float* __restrict__ cb, float (&out)[8]) {
    const float4 b0 = *(const float4*)(cb + ch * 8), b1 = *(const float4*)(cb + ch * 8 + 4);
    out[0] = b0.x; out[1] = b0.y; out[2] = b0.z; out[3] = b0.w; out[4] = b1.x; out[5] = b1.y; out[6] = b1.z; out[7] = b1.w;
#pragma unroll
    for (int j = 0; j < 4; ++j) {
        const int sp = sg - 3 + j;
        u32x4 v = {0u, 0u, 0u, 0u};
        if (sp >= 0) v = *(const u32x4*)(raw + ((size_t)ch * S_ + sp) * 8);
        const float4 w0 = *(const float4*)(cw + j * 768 + ch * 8), w1 = *(const float4*)(cw + j * 768 + ch * 8 + 4);
        out[0] += bflo(v[0]) * w0.x; out[1] += bfhi(v[0]) * w0.y; out[2] += bflo(v[1]) * w0.z; out[3] += bfhi(v[1]) * w0.w;
        out[4] += bflo(v[2]) * w1.x; out[5] += bfhi(v[2]) * w1.y; out[6] += bflo(v[3]) * w1.z; out[7] += bfhi(v[3]) * w1.w;
    }
#pragma unroll
    for (int i = 0; i < 8; ++i) out[i] = silu_f(out[i]);
}
__device__ __forceinline__ u32x4 pack8(const float (&v)[8], const float sc) {
    u32x4 o; o[0] = pk2(v[0] * sc, v[1] * sc); o[1] = pk2(v[2] * sc, v[3] * sc); o[2] = pk2(v[4] * sc, v[5] * sc); o[3] = pk2(v[6] * sc, v[7] * sc); return o;
}
__device__ __forceinline__ bf16x8 trfrag(const char* p, const int second) {
    const s16x4 a = vtr(p), b = vtr(p + second);
    return __builtin_shufflevector(a, b, 0, 1, 2, 3, 4, 5, 6, 7);
}
constexpr int MLA_LDS = 2048 + 32768 + 1024;
__device__ __forceinline__ void d_ml_a(const int unit, const bfu* __restrict__ mkr, const bfu* __restrict__ mvr, const float* __restrict__ gi, const float* __restrict__ glf,
                                       const float* __restrict__ cw, const float* __restrict__ cb, float* __restrict__ Wloc, float* __restrict__ nloc, float* __restrict__ scal, char* lds) {
    const int bh = unit >> 5, c = unit & 31, hh = bh % 6;
    const int tid = otid(), lane = tid & 63, r = lane & 31, h = lane >> 5;
    const int wid = __builtin_amdgcn_readfirstlane(tid >> 6);
    float* s_ws = (float*)lds; float* s_a = s_ws + 128; float* s_b = s_a + 128; float* s_A = s_b + 128;
    char* KW = lds + 2048; char* VI = KW + 16384; float* s_ns = (float*)(VI + 16384);
    __syncthreads();
    if (wid == 0) {
        float bl, al;
        ml_scan(gi + (size_t)bh * S_ + c * 128, glf + (size_t)bh * S_ + c * 128, lane, s_b, s_a, s_A, bl, al);
        const float2 a2 = *(const float2*)(s_a + 2 * lane);
        *(float2*)(s_ws + 2 * lane) = make_float2(__expf(a2.x - al), __expf(a2.y - al));
        if (lane == 0) { scal[(size_t)unit * 2] = bl; scal[(size_t)unit * 2 + 1] = al; }
    }
    __syncthreads();
    const bfu* kraw = mkr + (size_t)bh * S_ * 64; const bfu* vraw = mvr + (size_t)bh * S_ * 64;
#pragma unroll 1
    for (int it = 0; it < 4; ++it) {
        const int item = tid + 256 * it, s = item >> 3, ch = item & 7;
        float kv[8]; conv8(kraw, c * 128 + s, ch, cw + 384 + hh * 64, cb + 384 + hh * 64, kv);
        const int off = (ch >> 2) * 8192 + s * 64 + (ch & 3) * 16;
        *(u32x4*)(KW + off) = pack8(kv, 0.125f * s_ws[s]);
        *(u32x4*)(VI + off) = *(const u32x4*)(vraw + ((size_t)ch * S_ + c * 128 + s) * 8);
    }
    __syncthreads();
    {
        const int dvt = wid >> 1, dkt = wid & 1;
        const int trn = ((lane >> 4) & 1) * 32 + (lane & 3) * 8 + (8 * h + ((lane & 15) >> 2)) * 64;
        f32x16 acc;
#pragma unroll
        for (int e = 0; e < 16; ++e) acc[e] = 0.f;
#pragma unroll
        for (int ks = 0; ks < 8; ++ks) {
            const bf16x8 af = trfrag(VI + dvt * 8192 + trn + ks * 1024, 256), bf = trfrag(KW + dkt * 8192 + trn + ks * 1024, 256);
            acc = MFMA32(af, bf, acc);
        }
        float* wp = Wloc + (size_t)unit * 4096 + (size_t)(32 * dvt) * 64 + 32 * dkt + r;
#pragma unroll
        for (int e = 0; e < 16; ++e) wp[crow(e, h) * 64] = acc[e];
        const int dk = tid & 63, part = tid >> 6;
        float ns = 0.f;
        const char* kp = KW + (dk >> 5) * 8192 + (dk & 31) * 2 + part * 32 * 64;
#pragma unroll 8
        for (int s = 0; s < 32; ++s) ns += bf2f(*(const bfu*)(kp + s * 64));
        s_ns[part * 64 + dk] = ns;
    }
    __syncthreads();
    if (tid < 64) nloc[(size_t)unit * 64 + tid] = (s_ns[tid] + s_ns[64 + tid]) + (s_ns[128 + tid] + s_ns[192 + tid]);
}
constexpr int MLB_LDS = 2304 + 3 * 16384 + 8192;
__device__ __forceinline__ void d_ml_b(const int unit, const bfu* __restrict__ mqr, const bfu* __restrict__ mkr, const bfu* __restrict__ mvr, const bfu* __restrict__ mo,
                                       const float* __restrict__ gi, const float* __restrict__ glf, const float* __restrict__ cw, const float* __restrict__ cb,
                                       const float* __restrict__ Wloc, const float* __restrict__ nloc, const float* __restrict__ scal,
                                       const float* __restrict__ og, bfu* __restrict__ y, char* lds) {
    const int c = 31 - unit / 48, bh = unit % 48, b = bh / 6, hh = bh % 6;
    const int tid = otid(), lane = tid & 63, r = lane & 31, h = lane >> 5;
    const int wid = __builtin_amdgcn_readfirstlane(tid >> 6);
    float* s_b = (float*)lds; float* s_a = s_b + 128; float* s_A = s_a + 128; float* s_n = s_A + 128; float* s_coef = s_n + 64;
    float* s_dlog = s_coef + 32; float* s_alog = s_dlog + 32; float* s_mp = s_alog + 32;
    char* QI = lds + 2304; char* KI = QI + 16384; char* VI = KI + 16384; char* CI = VI + 16384;
    __syncthreads();
    if (wid == 0) { float bl, al; ml_scan(gi + (size_t)bh * S_ + c * 128, glf + (size_t)bh * S_ + c * 128, lane, s_b, s_a, s_A, bl, al); }
    else if (wid == 1) {
        float blv = 0.f, alv = 0.f;
        if (lane < c) { blv = scal[((size_t)bh * 32 + lane) * 2]; alv = scal[((size_t)bh * 32 + lane) * 2 + 1]; }
        float m = 0.f, mydl = 0.f, myal = 0.f;
        for (int j = 0; j < c; ++j) {
            const float bl = __shfl(blv, j, 64), al = __shfl(alv, j, 64);
            const float M = fmaxf(m, al);
            if (lane == j) { mydl = m - M; myal = al - M; }
            m = bl + M;
        }
        if (lane < 32) { s_dlog[lane] = mydl; s_alog[lane] = myal; }
        if (lane == 0) s_mp[0] = m;
    }
    {
        const bfu* qraw = mqr + (size_t)bh * S_ * 64; const bfu* kraw = mkr + (size_t)bh * S_ * 64; const bfu* vraw = mvr + (size_t)bh * S_ * 64;
#pragma unroll 1
        for (int it = 0; it < 4; ++it) {
            const int item = tid + 256 * it, s = item >> 3, ch = item & 7;
            float v8[8];
            conv8(qraw, c * 128 + s, ch, cw + hh * 64, cb + hh * 64, v8);
            const int ro = s * 128 + ((ch ^ (s & 7)) << 4);
            *(u32x4*)(QI + ro) = pack8(v8, 1.f);
            conv8(kraw, c * 128 + s, ch, cw + 384 + hh * 64, cb + 384 + hh * 64, v8);
            *(u32x4*)(KI + ro) = pack8(v8, 0.125f);
            *(u32x4*)(VI + (ch >> 2) * 8192 + s * 64 + (ch & 3) * 16) = *(const u32x4*)(vraw + ((size_t)ch * S_ + c * 128 + s) * 8);
        }
    }
    __syncthreads();
    if (tid < 32) {
        float L = s_alog[tid];
        for (int j = tid + 1; j < c; ++j) L += s_dlog[j];
        s_coef[tid] = (tid < c) ? __expf(L) : 0.f;
    }
    __syncthreads();
    {
        float4 acc[4];
#pragma unroll
        for (int i = 0; i < 4; ++i) acc[i] = make_float4(0.f, 0.f, 0.f, 0.f);
        float nacc = 0.f;
        const float* wb = Wloc + (size_t)bh * 32 * 4096 + tid * 4;
#pragma unroll 2
        for (int j = 0; j < c; ++j) {
            const float cf = s_coef[j];
#pragma unroll
            for (int i = 0; i < 4; ++i) { const float4 w = *(const float4*)(wb + (size_t)j * 4096 + 1024 * i); acc[i].x += cf * w.x; acc[i].y += cf * w.y; acc[i].z += cf * w.z; acc[i].w += cf * w.w; }
            if (tid < 64) nacc += cf * nloc[((size_t)bh * 32 + j) * 64 + tid];
        }
#pragma unroll
        for (int i = 0; i < 4; ++i) {
            const int e = tid * 4 + 1024 * i, dv = e >> 6, dk = e & 63;
            *(uint2*)(CI + dv * 128 + (((dk >> 3) ^ (dv & 7)) << 4) + (dk & 7) * 2) = make_uint2(pk2(acc[i].x, acc[i].y), pk2(acc[i].z, acc[i].w));
        }
        if (tid < 64) s_n[tid] = nacc;
    }
    __syncthreads();
    {
        const int t = 32 * wid + r, tg = c * 128 + t, sw = r & 7;
        const float m_prev = s_mp[0];
        bf16x8 qf[4];
#pragma unroll
        for (int ks = 0; ks < 4; ++ks) qf[ks] = *(const bf16x8*)(QI + t * 128 + (((2 * ks + h) ^ sw) << 4));
        const float Mt = fmaxf(m_prev, s_A[t]);
        const float isc = __expf(m_prev - Mt);
        f32x16 n0, n1;
#pragma unroll
        for (int e = 0; e < 16; ++e) { n0[e] = 0.f; n1[e] = 0.f; }
        float dsum = 0.f;
        const int trp = ((lane >> 4) & 1) * 32 + (lane & 3) * 8 + (4 * h + ((lane & 15) >> 2)) * 64;
#pragma unroll 1
        for (int u = 0; u <= wid; ++u) {
            f32x16 pacc;
#pragma unroll
            for (int e = 0; e < 16; ++e) pacc[e] = 0.f;
#pragma unroll
            for (int ks = 0; ks < 4; ++ks) {
                const bf16x8 kf = *(const bf16x8*)(KI + (32 * u + r) * 128 + (((2 * ks + h) ^ sw) << 4));
                pacc = MFMA32(kf, qf[ks], pacc);
            }
            float pw[16];
#pragma unroll
            for (int g = 0; g < 4; ++g) {
                const float4 a4 = *(const float4*)(s_a + 32 * u + 8 * g + 4 * h);
                const float av[4] = {a4.x, a4.y, a4.z, a4.w};
#pragma unroll
                for (int i = 0; i < 4; ++i) {
                    float val = pacc[4 * g + i] * __expf(av[i] - Mt);
                    if (u == wid && (8 * g + 4 * h + i) > r) val = 0.f;
                    dsum += val; pw[4 * g + i] = val;
                }
            }
            u32x4 pa, pb;
#pragma unroll
            for (int i = 0; i < 4; ++i) { pa[i] = pk2(pw[2 * i], pw[2 * i + 1]); pb[i] = pk2(pw[8 + 2 * i], pw[8 + 2 * i + 1]); }
            const bf16x8 pf0 = __builtin_bit_cast(bf16x8, pa), pf1 = __builtin_bit_cast(bf16x8, pb);
            const char* vp = VI + trp + (2 * u) * 1024;
            n0 = MFMA32(trfrag(vp, 512), pf0, n0); n1 = MFMA32(trfrag(vp + 8192, 512), pf0, n1);
            n0 = MFMA32(trfrag(vp + 1024, 512), pf1, n0); n1 = MFMA32(trfrag(vp + 8192 + 1024, 512), pf1, n1);
        }
        f32x16 i0, i1;
#pragma unroll
        for (int e = 0; e < 16; ++e) { i0[e] = 0.f; i1[e] = 0.f; }
        float qn = 0.f;
#pragma unroll
        for (int ks = 0; ks < 4; ++ks) {
            const int co = ((2 * ks + h) ^ sw) << 4;
            const bf16x8 c0 = *(const bf16x8*)(CI + r * 128 + co), c1 = *(const bf16x8*)(CI + (32 + r) * 128 + co);
            i0 = MFMA32(c0, qf[ks], i0); i1 = MFMA32(c1, qf[ks], i1);
            const u32x4 qu = __builtin_bit_cast(u32x4, qf[ks]);
            const float4 na = *(const float4*)(s_n + 16 * ks + 8 * h), nb = *(const float4*)(s_n + 16 * ks + 8 * h + 4);
            qn += bflo(qu[0]) * na.x + bfhi(qu[0]) * na.y + bflo(qu[1]) * na.z + bfhi(qu[1]) * na.w + bflo(qu[2]) * nb.x + bfhi(qu[2]) * nb.y + bflo(qu[3]) * nb.z + bfhi(qu[3]) * nb.w;
        }
        float lo, hi2; swap32(dsum, lo, hi2); const float dtot = lo + hi2;
        swap32(qn, lo, hi2); const float qtot = lo + hi2;
        const float den = dtot + isc * qtot;
        const float mt = s_b[t] + Mt;
        const float inv = 1.f / fmaxf(fabsf(den), __expf(-mt));
        float ss = 0.f;
#pragma unroll
        for (int e = 0; e < 16; ++e) { n0[e] = (n0[e] + isc * i0[e]) * inv; n1[e] = (n1[e] + isc * i1[e]) * inv; ss += n0[e] * n0[e] + n1[e] * n1[e]; }
        swap32(ss, lo, hi2);
        const float rinv = rsqrtf((lo + hi2) * (1.f / 64) + EPS);
        const size_t trow = (size_t)b * S_ + tg;
        bfu* yp = y + act_off(trow, 384 + hh * 64) + 4 * h;
        const bfu* op = mo + ((size_t)hh * 8 * T_ + trow) * 8 + 4 * h;
        const float* gp = og + (6 + hh) * 64 + 4 * h;
#pragma unroll
        for (int g = 0; g < 4; ++g) {
            const float4 g0 = *(const float4*)(gp + 8 * g), g1 = *(const float4*)(gp + 32 + 8 * g);
            const uint2 o0 = *(const uint2*)(op + (size_t)g * T_ * 8), o1 = *(const uint2*)(op + (size_t)(4 + g) * T_ * 8);
            *(uint2*)(yp + 8 * g) = make_uint2(pk2(n0[4 * g] * rinv * g0.x * bflo(o0.x), n0[4 * g + 1] * rinv * g0.y * bfhi(o0.x)), pk2(n0[4 * g + 2] * rinv * g0.z * bflo(o0.y), n0[4 * g + 3] * rinv * g0.w * bfhi(o0.y)));
            *(uint2*)(yp + (size_t)T_ * 32 + 8 * g) = make_uint2(pk2(n1[4 * g] * rinv * g1.x * bflo(o1.x), n1[4 * g + 1] * rinv * g1.y * bfhi(o1.x)), pk2(n1[4 * g + 2] * rinv * g1.z * bflo(o1.y), n1[4 * g + 3] * rinv * g1.w * bfhi(o1.y)));
        }
    }
}
constexpr int SG_LDS = 16384;
__device__ __forceinline__ void d_sg2(const int unit, const bfu* __restrict__ su, const bfu* __restrict__ svh, const bfu* __restrict__ wm, const float* __restrict__ bs,
                                      const float* __restrict__ og, bfu* __restrict__ y, char* lds) {
    const int g = unit & 3, c = (unit >> 2) & 31, b = unit >> 7;
    const int tid = otid(), lane = tid & 63, r = lane & 31, h = lane >> 5;
    const int wid = __builtin_amdgcn_readfirstlane(tid >> 6);
    char* VI = lds;
    __syncthreads();
    const bfu* vraw = svh + ((size_t)b * 4 + g) * S_ * 64 + (size_t)c * 128 * 8;
#pragma unroll
    for (int it = 0; it < 4; ++it) {
        const int item = tid + 256 * it, s = item >> 3, ch = item & 7;
        *(u32x4*)(VI + (ch >> 2) * 8192 + s * 64 + (ch & 3) * 16) = *(const u32x4*)(vraw + ((size_t)ch * S_ + s) * 8);
    }
    __syncthreads();
    const int t = 32 * wid + r;
    const int trn = ((lane >> 4) & 1) * 32 + (lane & 3) * 8 + (8 * h + ((lane & 15) >> 2)) * 64;
    f32x16 a0, a1;
#pragma unroll
    for (int e = 0; e < 16; ++e) { a0[e] = 0.f; a1[e] = 0.f; }
    const bfu* wr = wm + ((size_t)g * 128 + t) * 128 + 8 * h;
#pragma unroll 1
    for (int ks = 0; ks < 2 * wid + 2; ++ks) {
        const bf16x8 wf = *(const bf16x8*)(wr + 16 * ks);
        a0 = MFMA32(trfrag(VI + trn + ks * 1024, 256), wf, a0);
        a1 = MFMA32(trfrag(VI + 8192 + trn + ks * 1024, 256), wf, a1);
    }
    const float bias = bs[g * 128 + t];
    const size_t trow = (size_t)b * S_ + c * 128 + t;
    const bfu* up = su + ((size_t)g * 8 * T_ + trow) * 8 + 4 * h;
    float ss = 0.f;
#pragma unroll
    for (int q = 0; q < 4; ++q) {
        const uint2 u0 = *(const uint2*)(up + (size_t)q * T_ * 8), u1 = *(const uint2*)(up + (size_t)(4 + q) * T_ * 8);
        a0[4 * q] = (a0[4 * q] + bias) * bflo(u0.x); a0[4 * q + 1] = (a0[4 * q + 1] + bias) * bfhi(u0.x); a0[4 * q + 2] = (a0[4 * q + 2] + bias) * bflo(u0.y); a0[4 * q + 3] = (a0[4 * q + 3] + bias) * bfhi(u0.y);
        a1[4 * q] = (a1[4 * q] + bias) * bflo(u1.x); a1[4 * q + 1] = (a1[4 * q + 1] + bias) * bfhi(u1.x); a1[4 * q + 2] = (a1[4 * q + 2] + bias) * bflo(u1.y); a1[4 * q + 3] = (a1[4 * q + 3] + bias) * bfhi(u1.y);
    }
#pragma unroll
    for (int e = 0; e < 16; ++e) ss += a0[e] * a0[e] + a1[e] * a1[e];
    float lo, hi2; swap32(ss, lo, hi2);
    const float rinv = rsqrtf((lo + hi2) * (1.f / 64) + EPS);
    bfu* yp = y + act_off(trow, 768 + g * 64) + 4 * h;
    const float* gp = og + (12 + g) * 64 + 4 * h;
#pragma unroll
    for (int q = 0; q < 4; ++q) {
        const float4 g0 = *(const float4*)(gp + 8 * q), g1 = *(const float4*)(gp + 32 + 8 * q);
        *(uint2*)(yp + 8 * q) = make_uint2(pk2(a0[4 * q] * rinv * g0.x, a0[4 * q + 1] * rinv * g0.y), pk2(a0[4 * q + 2] * rinv * g0.z, a0[4 * q + 3] * rinv * g0.w));
        *(uint2*)(yp + (size_t)T_ * 32 + 8 * q) = make_uint2(pk2(a1[4 * q] * rinv * g1.x, a1[4 * q + 1] * rinv * g1.y), pk2(a1[4 * q + 2] * rinv * g1.z, a1[4 * q + 3] * rinv * g1.w));
    }
}

#define CE_D(a, b) { const float hi_ = fmaxf(a, b), lo_ = fminf(a, b); a = hi_; b = lo_; }
template <int B>
__device__ __forceinline__ void sort16_desc(float (&v)[64]) {
#define C2_(a, b) CE_D(v[B + a], v[B + b])
    C2_(0, 13) C2_(1, 12) C2_(2, 15) C2_(3, 14) C2_(4, 8) C2_(5, 6) C2_(7, 11) C2_(9, 10)
    C2_(0, 5) C2_(1, 7) C2_(2, 9) C2_(3, 4) C2_(6, 13) C2_(8, 14) C2_(10, 15) C2_(11, 12)
    C2_(0, 1) C2_(2, 3) C2_(4, 5) C2_(6, 8) C2_(7, 9) C2_(10, 11) C2_(12, 13) C2_(14, 15)
    C2_(0, 2) C2_(1, 3) C2_(4, 10) C2_(5, 11) C2_(6, 7) C2_(8, 9) C2_(12, 14) C2_(13, 15)
    C2_(1, 2) C2_(3, 12) C2_(4, 6) C2_(5, 7) C2_(8, 10) C2_(9, 11) C2_(13, 14)
    C2_(1, 4) C2_(2, 6) C2_(5, 8) C2_(7, 10) C2_(9, 13) C2_(11, 14)
    C2_(2, 4) C2_(3, 6) C2_(9, 12) C2_(11, 13)
    C2_(3, 5) C2_(6, 8) C2_(7, 9) C2_(10, 12)
    C2_(3, 4) C2_(5, 6) C2_(7, 8) C2_(9, 10) C2_(11, 12)
    C2_(6, 7) C2_(8, 9)
#undef C2_
}
template <int A0, int B0>
__device__ __forceinline__ void merge_top16(float (&v)[64]) {
#pragma unroll
    for (int i = 0; i < 16; ++i) v[A0 + i] = fmaxf(v[A0 + i], v[B0 + 15 - i]);
#pragma unroll
    for (int j = 8; j > 0; j >>= 1)
#pragma unroll
        for (int i = 0; i < 16; ++i) { const int l = i ^ j; if (l > i) { CE_D(v[A0 + i], v[A0 + l]); } }
}
__device__ __forceinline__ void top16_of_64(float (&v)[64]) {
    sort16_desc<0>(v); sort16_desc<16>(v); sort16_desc<32>(v); sort16_desc<48>(v);
    merge_top16<0, 16>(v); merge_top16<32, 48>(v); merge_top16<0, 32>(v);
}
__device__ __forceinline__ void d_compose_wq(const int unit, const float* __restrict__ wq_all, const float* __restrict__ keys_all, bfu* __restrict__ wt_all) {
    const int l = unit >> 7, hc = (unit >> 3) & 15, kb = unit & 7;
    const int tid = otid(), lane = tid & 63, r = lane & 31, h = lane >> 5;
    const int w = __builtin_amdgcn_readfirstlane(tid >> 6);
    const float* wq = wq_all + (size_t)l * D_ * 2048 + (size_t)(kb * 128 + w * 32 + r) * 2048 + hc * 128 + 8 * h;
    const float* ky = keys_all + ((size_t)l * 16 + hc) * 128 * 128 + (size_t)r * 128 + 8 * h;
    bf16x8 af[8];
#pragma unroll
    for (int ks = 0; ks < 8; ++ks) {
        const float4 a = *(const float4*)(wq + 16 * ks), b = *(const float4*)(wq + 16 * ks + 4);
        u32x4 o; o[0] = pk2(a.x, a.y); o[1] = pk2(a.z, a.w); o[2] = pk2(b.x, b.y); o[3] = pk2(b.z, b.w);
        af[ks] = __builtin_bit_cast(bf16x8, o);
    }
    bfu* dst = wt_all + (size_t)l * 2048 * D_ + ((size_t)(kb * 4 + w) * 2048 + hc * 128 + r) * 32 + 4 * h;
#pragma unroll 1
    for (int nt = 0; nt < 4; ++nt) {
        f32x16 acc;
#pragma unroll
        for (int e = 0; e < 16; ++e) acc[e] = 0.f;
#pragma unroll
        for (int ks = 0; ks < 8; ++ks) {
            const float4 a = *(const float4*)(ky + (size_t)nt * 32 * 128 + 16 * ks), b = *(const float4*)(ky + (size_t)nt * 32 * 128 + 16 * ks + 4);
            u32x4 o; o[0] = pk2(a.x, a.y); o[1] = pk2(a.z, a.w); o[2] = pk2(b.x, b.y); o[3] = pk2(b.z, b.w);
            acc = MFMA32(af[ks], __builtin_bit_cast(bf16x8, o), acc);
        }
#pragma unroll
        for (int g = 0; g < 4; ++g)
            *(uint2*)(dst + (size_t)nt * 32 * 32 + 8 * g) = make_uint2(pk2(acc[4 * g], acc[4 * g + 1]), pk2(acc[4 * g + 2], acc[4 * g + 3]));
    }
}
struct EpiScore {
    float* TOPK;
    __device__ __forceinline__ void operator()(f32x16 (&acc)[2][4], int abase, int bbase, int r, int h, char* xl, int wa, int wb) const {
        const int hc = abase >> 7;
        const unsigned nb = (unsigned)(wa * 64 + 4 * h);
        float keep[2][16];
#pragma unroll
        for (int pass = 0; pass < 2; ++pass)
#pragma unroll
            for (int jj = 0; jj < 2; ++jj) {
                float v[64];
#pragma unroll
                for (int i = 0; i < 2; ++i)
#pragma unroll
                    for (int e = 0; e < 16; ++e) {
                        const float lo = acc[i][jj][e], hi = acc[i][2 + jj][e];
                        const float x = (pass == 0) ? (wa ? lo : hi) : (wa ? hi : lo);
                        v[16 * i + e] = __uint_as_float((__float_as_uint(x) & 0xFFFFFF80u) | (nb + (unsigned)(32 * i + (e & 3) + 8 * (e >> 2))));
                    }
                sort16_desc<0>(v); sort16_desc<16>(v); merge_top16<0, 16>(v);
#pragma unroll
                for (int i = 0; i < 16; ++i) { float lo, hi2; swap32(v[i], lo, hi2); v[16 + i] = h ? lo : hi2; }
                merge_top16<0, 16>(v);
                if (pass == 0) {
                    if (h == 0) {
                        float4* sp = (float4*)(xl + ((((wb * 2 + wa) * 2 + jj) * 32 + r) << 6));
#pragma unroll
                        for (int q = 0; q < 4; ++q) sp[q] = make_float4(v[4 * q], v[4 * q + 1], v[4 * q + 2], v[4 * q + 3]);
                    }
                } else {
#pragma unroll
                    for (int i = 0; i < 16; ++i) keep[jj][i] = v[i];
                }
            }
        __syncthreads();
#pragma unroll
        for (int jj = 0; jj < 2; ++jj) {
            float v[64];
            const float4* sp = (const float4*)(xl + ((((wb * 2 + (wa ^ 1)) * 2 + jj) * 32 + r) << 6));
#pragma unroll
            for (int q = 0; q < 4; ++q) { const float4 t4 = sp[q]; v[16 + 4 * q] = t4.x; v[16 + 4 * q + 1] = t4.y; v[16 + 4 * q + 2] = t4.z; v[16 + 4 * q + 3] = t4.w; }
#pragma unroll
            for (int i = 0; i < 16; ++i) v[i] = keep[jj][i];
            merge_top16<0, 16>(v);
            const int token = bbase + 32 * (wa ? 2 + jj : jj) + r;
            float4* dp = (float4*)(TOPK + ((size_t)token * 16 + hc) * 16 + 8 * h);
            if (h == 0) { dp[0] = make_float4(v[0], v[1], v[2], v[3]); dp[1] = make_float4(v[4], v[5], v[6], v[7]); }
            else { dp[0] = make_float4(v[8], v[9], v[10], v[11]); dp[1] = make_float4(v[12], v[13], v[14], v[15]); }
        }
        __syncthreads();
    }
};
__device__ __forceinline__ void d_peer_cand(const int vb, const float* __restrict__ topk, int* __restrict__ idx, float* __restrict__ gate) {
    const size_t pidx = (size_t)vb * 256 + otid();
    const float4* tp = (const float4*)(topk + pidx * 32);
    float top[2][16];
#pragma unroll
    for (int c = 0; c < 2; ++c)
#pragma unroll
        for (int q = 0; q < 4; ++q) { const float4 t4 = tp[4 * c + q]; top[c][4 * q] = t4.x; top[c][4 * q + 1] = t4.y; top[c][4 * q + 2] = t4.z; top[c][4 * q + 3] = t4.w; }
    float cd[64];
    {
        unsigned i1[16], i2[16];
#pragma unroll
        for (int i = 0; i < 16; ++i) { i1[i] = (__float_as_uint(top[0][i]) & 127u) << 7; i2[i] = __float_as_uint(top[1][i]) & 127u; }
#define CAND_(i, j) __uint_as_float((__float_as_uint(top[0][i] + top[1][j]) & 0xFFFFC000u) | i1[i] | i2[j])
#pragma unroll
        for (int q = 0; q < 16; ++q) { cd[q] = CAND_(0, q); cd[32 + q] = (q < 15) ? CAND_((q < 15 ? q + 1 : 15), 0) : -INFINITY; }
        int n = 0;
#pragma unroll
        for (int i = 1; i < 8; ++i)
#pragma unroll
            for (int jj = 1; jj < 8; ++jj)
                if ((i + 1) * (jj + 1) <= 16) { if (n < 16) cd[16 + n] = CAND_(i, jj); else cd[48 + n - 16] = CAND_(i, jj); ++n; }
#undef CAND_
#pragma unroll
        for (int q = 3; q < 16; ++q) cd[48 + q] = -INFINITY;
    }
    sort16_desc<16>(cd); merge_top16<0, 16>(cd);
    sort16_desc<48>(cd); merge_top16<32, 48>(cd);
#pragma unroll
    for (int i = 0; i < 16; ++i) cd[i] = fmaxf(cd[i], cd[47 - i]);
    float gsum = 0.f; float gv[16]; int ids[16];
    const float vmax = __uint_as_float(__float_as_uint(top[0][0] + top[1][0]) & 0xFFFFC000u);
#pragma unroll
    for (int i = 0; i < 16; ++i) {
        const unsigned b = __float_as_uint(cd[i]);
        ids[i] = (int)(b & 0x3FFFu);
        gv[i] = __expf(__uint_as_float(b & 0xFFFFC000u) - vmax); gsum += gv[i];
    }
    const float ginv = 1.f / gsum;
    int4* ip = (int4*)(idx + pidx * 16); float4* gp = (float4*)(gate + pidx * 16);
#pragma unroll
    for (int i = 0; i < 4; ++i) {
        ip[i] = make_int4(ids[4 * i], ids[4 * i + 1], ids[4 * i + 2], ids[4 * i + 3]);
        gp[i] = make_float4(gv[4 * i] * ginv, gv[4 * i + 1] * ginv, gv[4 * i + 2] * ginv, gv[4 * i + 3] * ginv);
    }
}
constexpr int ROUTE_LDS = 65536;
__device__ __forceinline__ void d_peer_route3(const int bid, const int G, const bfu* __restrict__ pq, const bfu* __restrict__ keys, int* __restrict__ idx, float* __restrict__ gate, char* lds) {
    const int hd = bid & 7, tb0 = bid >> 3, tstep = G >> 3, NTB = T_ / 128;
    if (tb0 >= NTB) return;
    const int tid = otid();
    const int wid = __builtin_amdgcn_readfirstlane(tid >> 6);
    bf16x8 qf0[8];
    {
        const int lane = tid & 63;
        const bfu* qrow = pq + ((size_t)(hd * 32 + (lane >> 5)) * T_ + tb0 * 128 + wid * 32 + (lane & 31)) * 8;
#pragma unroll
        for (int ks = 0; ks < 8; ++ks) qf0[ks] = *(const bf16x8*)(qrow + (size_t)(2 * ks) * T_ * 8);
    }
    __syncthreads();
    {
        const bfu* kg = keys + (size_t)hd * 2 * 128 * 128;
#pragma unroll
        for (int it = 0; it < 16; ++it) {
            const int cidx = tid + 256 * it, n = cidx >> 4, ch = cidx & 15;
            *(u32x4*)(lds + n * 256 + ((ch ^ (n & 15)) << 4)) = *(const u32x4*)(kg + (size_t)cidx * 8);
        }
    }
    __syncthreads();
#pragma unroll 1
    for (int tb = tb0; tb < NTB; tb += tstep) {
        const int lane = otid() & 63, r = lane & 31, h = lane >> 5;
        const bfu* qbase = pq + ((size_t)(hd * 32 + h) * T_ + wid * 32 + r) * 8;
        const int t = tb * 128 + wid * 32 + r;
        const int tbn = (tb + tstep < NTB) ? tb + tstep : tb;
        float top[2][16];
        bf16x8 qf1[8];
        {
            const bfu* qrow = qbase + (size_t)tb * 128 * 8;
#pragma unroll
            for (int ks = 0; ks < 8; ++ks) qf1[ks] = *(const bf16x8*)(qrow + (size_t)(16 + 2 * ks) * T_ * 8);
        }
#pragma unroll
        for (int c = 0; c < 2; ++c) {
            float v[64];
#pragma unroll
            for (int mt = 0; mt < 4; ++mt) {
                f32x16 acc;
#pragma unroll
                for (int e = 0; e < 16; ++e) acc[e] = 0.f;
                const char* kb = lds + c * 32768 + (32 * mt + r) * 256;
#pragma unroll
                for (int ks = 0; ks < 8; ++ks) acc = MFMA32(*(const bf16x8*)(kb + (((2 * ks + h) ^ (r & 15)) << 4)), c ? qf1[ks] : qf0[ks], acc);
#pragma unroll
                for (int e = 0; e < 16; ++e) {
                    const unsigned n = (unsigned)(32 * mt + (e & 3) + 8 * (e >> 2)) | (unsigned)(4 * h);
                    v[16 * mt + e] = __uint_as_float((__float_as_uint(acc[e]) & 0xFFFFFF80u) | n);
                }
            }
            if (c) {
                const bfu* qrow = qbase + (size_t)tbn * 128 * 8;
#pragma unroll
                for (int ks = 0; ks < 8; ++ks) qf0[ks] = *(const bf16x8*)(qrow + (size_t)(2 * ks) * T_ * 8);
            }
            top16_of_64(v);
#pragma unroll
            for (int i = 0; i < 16; ++i) { float lo, hi2; swap32(v[i], lo, hi2); v[16 + i] = h ? lo : hi2; }
            merge_top16<0, 16>(v);
#pragma unroll
            for (int i = 0; i < 16; ++i) top[c][i] = v[i];
        }
        float cd[64];
        {
            unsigned i1[16], i2[16];
#pragma unroll
            for (int i = 0; i < 16; ++i) { i1[i] = (__float_as_uint(top[0][i]) & 127u) << 7; i2[i] = __float_as_uint(top[1][i]) & 127u; }
#define CAND_(i, j) __uint_as_float((__float_as_uint(top[0][i] + top[1][j]) & 0xFFFFC000u) | i1[i] | i2[j])
#pragma unroll
            for (int q = 0; q < 16; ++q) {
                const float a = CAND_(0, q), b = (q < 15) ? CAND_((q < 15 ? q + 1 : 15), 0) : -INFINITY;
                cd[q] = h ? b : a;
            }
            float cx[19];
            {
                int n = 0;
#pragma unroll
                for (int i = 1; i < 8; ++i)
#pragma unroll
                    for (int jj = 1; jj < 8; ++jj)
                        if ((i + 1) * (jj + 1) <= 16) { cx[n] = CAND_(i, jj); ++n; }
            }
#undef CAND_
#pragma unroll
            for (int q = 0; q < 16; ++q) cd[16 + q] = h ? (q < 3 ? cx[16 + q] : -INFINITY) : cx[q];
        }
        sort16_desc<16>(cd);
        merge_top16<0, 16>(cd);
#pragma unroll
        for (int i = 0; i < 16; ++i) { float lo, hi2; swap32(cd[i], lo, hi2); cd[16 + i] = lo; cd[32 + i] = hi2; }
#pragma unroll
        for (int i = 0; i < 16; ++i) cd[i] = fmaxf(cd[16 + i], cd[47 - i]);
        float gsum = 0.f; float gv[16]; int ids[16];
        const float vmax = __uint_as_float(__float_as_uint(top[0][0] + top[1][0]) & 0xFFFFC000u);
#pragma unroll
        for (int i = 0; i < 16; ++i) {
            const unsigned b = __float_as_uint(cd[i]);
            ids[i] = (int)(b & 0x3FFFu);
            gv[i] = __expf(__uint_as_float(b & 0xFFFFC000u) - vmax); gsum += gv[i];
        }
        const float ginv = 1.f / gsum;
        if (h == 0) {
            int4* ip = (int4*)(idx + (size_t)t * 128 + hd * 16);
#pragma unroll
            for (int i = 0; i < 4; ++i) ip[i] = make_int4(ids[4 * i], ids[4 * i + 1], ids[4 * i + 2], ids[4 * i + 3]);
        } else {
            float4* gp = (float4*)(gate + (size_t)t * 128 + hd * 16);
#pragma unroll
            for (int i = 0; i < 4; ++i) gp[i] = make_float4(gv[4 * i] * ginv, gv[4 * i + 1] * ginv, gv[4 * i + 2] * ginv, gv[4 * i + 3] * ginv);
        }
    }
}

struct Params {
    const float* in[19];
    float* out;
    char* ws;
    int ph_lo, ph_hi;
};
constexpr size_t al256(size_t x) { return (x + 255) & ~(size_t)255; }
constexpr size_t WS_BAR = 0;
constexpr size_t WS_A = al256(XCD_BAR_WORDS * 4);
constexpr size_t WS_GI = WS_A + al256((size_t)T_ * D_ * 2);
constexpr size_t WS_GLF = WS_GI + al256((size_t)T_ * 6 * 4);
constexpr size_t WS_IDX = WS_GLF + al256((size_t)T_ * 6 * 4);
constexpr size_t WS_GATE = WS_IDX + al256((size_t)T_ * 128 * 4);
constexpr int NIN = 3200;
constexpr size_t WS_WTIN = WS_GATE + al256((size_t)T_ * 128 * 4);
constexpr size_t WS_WTOUT = WS_WTIN + al256((size_t)DEPTH_ * NIN * D_ * 2);
constexpr size_t WS_WTQ = WS_WTOUT + al256((size_t)DEPTH_ * D_ * D_ * 2);
constexpr size_t WS_TU = WS_WTQ + al256((size_t)DEPTH_ * 2048 * D_ * 2);
constexpr size_t WS_TV = WS_TU + al256((size_t)16384 * D_ * 2);
constexpr size_t WS_SBQ = WS_TV + al256((size_t)16384 * D_ * 2);
constexpr size_t WS_MLQ = WS_SBQ + al256((size_t)3 * T_ * 384 * 2);
constexpr size_t WS_MLO = WS_MLQ + al256((size_t)3 * T_ * 384 * 2);
constexpr size_t WS_SGU = WS_MLO + al256((size_t)T_ * 384 * 2);
constexpr size_t WS_SGV = WS_SGU + al256((size_t)T_ * 256 * 2);
constexpr size_t WS_WLOC = WS_SGV + al256((size_t)T_ * 256 * 2);
constexpr size_t WS_NLOC = WS_WLOC + al256((size_t)48 * 32 * 4096 * 4);
constexpr size_t WS_SCAL = WS_NLOC + al256((size_t)48 * 32 * 64 * 4);
constexpr size_t WS_SGW = WS_SCAL + al256((size_t)48 * 32 * 2 * 4);
constexpr size_t WS_WG = WS_SGW + al256((size_t)DEPTH_ * 4 * 128 * 128 * 2);
constexpr size_t WS_PQ = WS_WG + al256((size_t)DEPTH_ * 12 * 1024 * 4);
constexpr size_t WS_KEYS = WS_PQ + al256((size_t)T_ * 2048 * 2);
constexpr size_t WS_USC = WS_KEYS + al256((size_t)DEPTH_ * 8 * 2 * 128 * 128 * 2);
constexpr size_t WS_VSC = WS_USC + al256(16384 * 4);
constexpr size_t WS_END = WS_VSC + al256(16384 * 4);
constexpr int NPH = 9;
constexpr int LDS_BYTES = 16 + GEMM_LDS;
static_assert(MLB_LDS <= GEMM_LDS && MLA_LDS <= GEMM_LDS && SBA_LDS + 32 <= GEMM_LDS, "lds");

__global__ void __launch_bounds__(256, 2) mk_fwd(Params p) {
    extern __shared__ __attribute__((aligned(16))) char lds[];
    if (threadIdx.x == 0) *(uint4*)lds = make_uint4(0u, 0u, 0u, 0u);
    __syncthreads();
    XcdBarrier bar = xcd_barrier_post((unsigned*)(p.ws + WS_BAR), (volatile LAS unsigned*)lds);
    float* sm = (float*)(lds + 16);
    char* smc = lds + 16;
    const int G = gridDim.x, bid = blockIdx.x;
    float* topk = (float*)(p.ws + WS_PQ);
    bfu* bufA = (bfu*)(p.ws + WS_A);
    float* gi = (float*)(p.ws + WS_GI); float* glf = (float*)(p.ws + WS_GLF);
    int* idx = (int*)(p.ws + WS_IDX); float* gate = (float*)(p.ws + WS_GATE);
    bfu* wtin = (bfu*)(p.ws + WS_WTIN); bfu* wtout = (bfu*)(p.ws + WS_WTOUT); bfu* wtq = (bfu*)(p.ws + WS_WTQ);
    unsigned char* tu = (unsigned char*)(p.ws + WS_TU); unsigned char* tv = (unsigned char*)(p.ws + WS_TV); float* usc = (float*)(p.ws + WS_USC); float* vsc = (float*)(p.ws + WS_VSC);
    bfu* sbq = (bfu*)(p.ws + WS_SBQ); bfu* sbk = sbq + (size_t)T_ * 384; bfu* sbv = sbk + (size_t)T_ * 384;
    bfu* mlq = (bfu*)(p.ws + WS_MLQ); bfu* mlk = mlq + (size_t)T_ * 384; bfu* mlv = mlk + (size_t)T_ * 384;
    bfu* mlo = (bfu*)(p.ws + WS_MLO); bfu* sgu = (bfu*)(p.ws + WS_SGU); bfu* sgv = (bfu*)(p.ws + WS_SGV);
    float* wloc = (float*)(p.ws + WS_WLOC); float* nloc = (float*)(p.ws + WS_NLOC); float* scal = (float*)(p.ws + WS_SCAL);
    bfu* sgw = (bfu*)(p.ws + WS_SGW); float* wgc = (float*)(p.ws + WS_WG);
    float* xo = p.out;
    const int lo = p.ph_lo, hi = p.ph_hi;
#ifndef DUP_MASK
#define DUP_MASK 0
#endif
#define DUPK(ph) ((ph) == 0 ? 0 : 1 + ((ph) - 1) % NPH)
#define PHASE_ID(ph, NB, ...) { const int ph_ = (ph); if (lo <= ph_ && ph_ < hi) { for (int rep_ = 0; rep_ <= ((DUP_MASK >> DUPK(ph_)) & 1); ++rep_) for (int vb = bid; vb < (NB); vb += G) { __VA_ARGS__; } if (ph_ + 1 < hi) xcd_barrier(bar); } }
#define PHASE(k, NB, ...) PHASE_ID(1 + l * NPH + (k), NB, __VA_ARGS__)
#define GEMM_PHASE(k, NTT, NFT, TOKA, AP, BP, RSA, KTSA, RSB, KTSB, ...) { const int ph_ = 1 + l * NPH + (k); if (lo <= ph_ && ph_ < hi) { \
        __VA_ARGS__; const UnitMap um_{bid & 7, (NTT), (NFT), (TOKA)}; const OpLay ol_{(RSA), (KTSA), (RSB), (KTSB)}; \
        for (int rep_ = 0; rep_ <= ((DUP_MASK >> DUPK(ph_)) & 1); ++rep_) gemm_stream((AP), (BP), smc, e, um_, ol_, bid >> 3, G >> 3); \
        if (ph_ + 1 < hi) xcd_barrier(bar); } }
    PHASE_ID(0, DEPTH_ * (800 + 256) + 128 + 16 + 512, {
        if (vb < DEPTH_ * 1056) {
            const int l = vb / 1056, u = vb % 1056;
            if (u < 800) d_transpose_w<true>(u, p.in[2] + (size_t)l * D_ * INW, wtin + (size_t)l * NIN * D_, INW, 50, sm);
            else d_transpose_w<false>(u - 800, p.in[13] + (size_t)l * D_ * D_, wtout + (size_t)l * D_ * D_, D_, 16, sm);
        } else if (vb < DEPTH_ * 1056 + 128) d_cvt_sgw(vb - DEPTH_ * 1056, p.in[10], sgw);
        else if (vb < DEPTH_ * 1056 + 144) d_gatew(vb - DEPTH_ * 1056 - 128, p.in[2], wgc);
        else d_compose_wq(vb - DEPTH_ * 1056 - 144, p.in[15], p.in[16], wtq);
    })
    for (int l = 0; l < DEPTH_; ++l) {
        const float* xcur = (l == 0) ? p.in[0] : xo;
        const float* og = p.in[12] + (size_t)l * D_;
        const float* cw = p.in[5] + (size_t)l * 4 * 768; const float* cb = p.in[6] + l * 768;
        {
            const int ph_ = 1 + l * NPH + 0;
            if (l == 0 && lo <= ph_ && ph_ < hi) {
                __syncthreads();
                for (int e = otid(); e < 3072; e += 256) *(float4*)(sm + e * 4) = *(const float4*)(wgc + (size_t)l * 12288 + e * 4);
                __syncthreads();
                for (int rep_ = 0; rep_ <= ((DUP_MASK >> 1) & 1); ++rep_) for (int vb = bid; vb < T_ / 4; vb += G) d_rmsnorm<true>(vb, xcur, p.in[1] + (size_t)l * D_, bufA, sm, p.in[7] + l * 6, p.in[8] + l * 6, gi, glf);
                if (ph_ + 1 < hi) xcd_barrier(bar);
            }
        }
        {
            const int ph_ = 1 + l * NPH + 1;
            if (lo <= ph_ && ph_ < hi) {
                const EpiIn e{p.in[3] + l * 64, p.in[4] + l * 64, p.in[9] + l * 256, sbq, sbk, sbv, mlq, mlk, mlv, mlo, sgu, sgv};
                const UnitMap um_{bid & 7, 16, 25, 0}; const OpLay ol_{32, NIN * 32, 32, T_ * 32};
                for (int rep_ = 0; rep_ <= ((DUP_MASK >> DUPK(ph_)) & 1); ++rep_) gemm_stream(wtin + (size_t)l * NIN * D_, bufA, smc, e, um_, ol_, bid >> 3, G >> 3);
                const int step = G >> 3, maxu = (400 + step - 1) / step, thr = 400 - (maxu - 1) * step;
                int rank = bid, nb = G;
                if (thr < step) { rank = ((bid >> 3) - thr) * 8 + (bid & 7); nb = (step - thr) * 8; }
                if (rank >= 0)
                    for (int vb = rank; vb < 4096; vb += nb) {
                        if (vb < 2048) d_cvt_i4x2<true>(vb, p.in[17] + (size_t)l * 16384 * D_, tu, usc);
                        else d_cvt_i4x2<false>(vb - 2048, p.in[18] + (size_t)l * 16384 * D_, tu + 8, vsc);
                    }
                if (ph_ + 1 < hi) xcd_barrier(bar);
            }
        }
        {
            const int ph_ = 1 + l * NPH + 2;
            if (lo <= ph_ && ph_ < hi) {
                for (int rep_ = 0; rep_ <= ((DUP_MASK >> 3) & 1); ++rep_) {
                for (int j = 0; j * G < 1536; ++j) { const int u = j * G + ((j & 1) ? (G - 1 - bid) : bid); if (u < 1536) d_sb_attn2(u, sbq, sbk, sbv, og, bufA, smc); }
                for (int u = bid; u < 1536; u += G) d_ml_a(u, mlk, mlv, gi, glf, cw, cb, wloc, nloc, scal, smc);
                for (int u = bid; u < 1024; u += G) d_sg2(u, sgu, sgv, sgw + (size_t)l * 4 * 128 * 128, p.in[11] + l * 4 * 128, og, bufA, smc);
                }
                if (ph_ + 1 < hi) xcd_barrier(bar);
            }
        }
        PHASE(3, 1536, d_ml_b(vb, mlq, mlk, mlv, mlo, gi, glf, cw, cb, wloc, nloc, scal, og, bufA, smc))
        GEMM_PHASE(4, 32, 4, 1, bufA, wtout + (size_t)l * D_ * D_, 32, T_ * 32, 32, D_ * 32, const EpiF32<true, false> e{xcur, xo, D_})
        PHASE(5, T_ / 4, d_rmsnorm<false>(vb, xo, p.in[14] + (size_t)l * D_, bufA, nullptr, nullptr, nullptr, nullptr, nullptr))
        GEMM_PHASE(6, 16, 16, 0, wtq + (size_t)l * 2048 * D_, bufA, 32, 2048 * 32, 32, T_ * 32, const EpiScore e{topk})
        PHASE(7, T_ * 8 / 256, d_peer_cand(vb, topk, idx, gate))
        {
            const int ph_ = 1 + l * NPH + 8;
            if (lo <= ph_ && ph_ < hi) {
                if (l + 1 < DEPTH_) {
                    __syncthreads();
                    for (int e = otid(); e < 3072; e += 256) *(float4*)(sm + e * 4) = *(const float4*)(wgc + (size_t)(l + 1) * 12288 + e * 4);
                    __syncthreads();
                    for (int vb = bid; vb < T_ / 4; vb += G)
                        d_peer_expert5<true>(vb, bufA, idx, gate, tu, tv, usc, vsc, xo, p.in[1] + (size_t)(l + 1) * D_, sm, p.in[7] + (l + 1) * 6, p.in[8] + (l + 1) * 6, gi, glf);
                } else {
                    for (int vb = bid; vb < T_ / 4; vb += G) d_peer_expert5<false>(vb, bufA, idx, gate, tu, tv, usc, vsc, xo, nullptr, nullptr, nullptr, nullptr, nullptr, nullptr);
                }
                if (ph_ + 1 < hi) xcd_barrier(bar);
            }
        }
    }
}

extern "C" void kernel_launch(void* const* d_in, const int* in_sizes, int n_in, void* d_out, int out_size, void* d_ws, size_t ws_size, hipStream_t stream) {
    static int grid = 0;
    if (grid == 0) {
        int dev = 0, cus = 0, per_cu = 0;
        (void)hipGetDevice(&dev);
        (void)hipDeviceGetAttribute(&cus, hipDeviceAttributeMultiprocessorCount, dev);
        (void)hipFuncSetAttribute((const void*)mk_fwd, hipFuncAttributeMaxDynamicSharedMemorySize, LDS_BYTES);
        (void)hipOccupancyMaxActiveBlocksPerMultiprocessor(&per_cu, (const void*)mk_fwd, 256, LDS_BYTES);
        if (per_cu < 1) per_cu = 1;
        if (per_cu > 2) per_cu = 2;
        if (cus <= 0) cus = 256;
        grid = cus * per_cu;
        grid -= grid % 8;
        if (grid < 8) grid = 8;
        (void)hipGetLastError();
    }
    if (ws_size < WS_END) return;
    (void)hipMemsetAsync((char*)d_ws + WS_BAR, 0, XCD_BAR_WORDS * 4, stream);
    Params p{};
    for (int i = 0; i < 19; ++i) p.in[i] = (const float*)d_in[i];
    p.out = (float*)d_out; p.ws = (char*)d_ws; p.ph_lo = 0; p.ph_hi = 1 + DEPTH_ * NPH;
    hipLaunchKernelGGL(mk_fwd, dim3(grid), dim3(256), LDS_BYTES, stream, p);
}
```

```cpp
#include <hip/hip_runtime.h>
#include <stdint.h>
#include <math.h>

constexpr int B_ = 8, S_ = 4096, D_ = 1024, T_ = B_ * S_, DEPTH_ = 4;
constexpr int INW = 3212;
constexpr int ZQ = 0, ZK = 384, ZV = 768, ZMQ = 1152, ZMV = 1920, ZMO = 2304, ZMI = 2688, ZMF = 2694, ZSU = 2700, ZSV = 2956;
constexpr float EPS = 1e-6f;

#define XB_TMO      128
#define XB_XCNT(j)  (256  + 64 * (j))
#define XB_XSUB(j)  (1280 + 64 * (j))
#define XB_XGEN(j)  (2304 + 64 * (j))
#define XB_TOP      3328
#define XB_TOPGEN   3392
#define XCD_BAR_WORDS 3456
#define XB_SPIN_CAP (1u << 21)
#define LAS __attribute__((address_space(3)))

__device__ __forceinline__ unsigned xb_ld(unsigned* p)              { return __hip_atomic_load(p, __ATOMIC_RELAXED, __HIP_MEMORY_SCOPE_AGENT); }
__device__ __forceinline__ unsigned xb_add(unsigned* p, unsigned v) { return __hip_atomic_fetch_add(p, v, __ATOMIC_RELAXED, __HIP_MEMORY_SCOPE_AGENT); }
__device__ __forceinline__ unsigned xb_xcc_id() { return (unsigned)__builtin_amdgcn_s_getreg((3 << 11) | 20) & 0xFu; }
#define XB_SPIN(cond, bar) do { unsigned _sp = 0; while (cond) { __builtin_amdgcn_s_sleep(1); \
    if ((++_sp & 255u) == 0u) { if (xb_ld(&(bar)[XB_TMO])) break; if (_sp > XB_SPIN_CAP) { atomicAdd(&(bar)[XB_TMO], 1u); break; } } } } while (0)

struct XcdBarrier {
    unsigned* bar; unsigned x;
    volatile LAS unsigned* st;
};

__device__ __forceinline__ XcdBarrier xcd_barrier_post(unsigned* bar, volatile LAS unsigned* st) {
    XcdBarrier b; b.bar = bar; b.x = xb_xcc_id(); b.st = st;
    if (threadIdx.x == 0) (void)xb_add(&bar[XB_XCNT(b.x)], 1u);
    return b;
}
__device__ __forceinline__ void xcd_barrier_complete(unsigned* bar, unsigned x, unsigned& nloc, unsigned& nx) {
    const unsigned G = gridDim.x * gridDim.y * gridDim.z;
    unsigned sum, cnt, mine, sp = 0u;
    for (;;) {
        sum = 0u; cnt = 0u; mine = 0u;
#pragma unroll
        for (unsigned j = 0; j < 16; ++j) { const unsigned c = xb_ld(&bar[XB_XCNT(j)]); sum += c; cnt += (c > 0u) ? 1u : 0u; mine = (j == x) ? c : mine; }
        if (sum == G) break;
        __builtin_amdgcn_s_sleep(1);
        if ((++sp & 255u) == 0u) { if (xb_ld(&bar[XB_TMO])) break; if (sp > XB_SPIN_CAP) { atomicAdd(&bar[XB_TMO], 1u); break; } }
    }
    nloc = mine > 0u ? mine : 1u; nx = cnt > 0u ? cnt : 1u;
}

__device__ __forceinline__ void xcd_barrier(const XcdBarrier& b) {
    asm volatile("s_waitcnt vmcnt(0)" ::: "memory");
    __syncthreads();
    if (threadIdx.x == 0) {
        unsigned* bar = b.bar;
        __builtin_amdgcn_s_waitcnt(0);
        unsigned nloc = b.st[0], nx = b.st[1];
        if (nloc == 0u) { xcd_barrier_complete(bar, b.x, nloc, nx); b.st[0] = nloc; b.st[1] = nx; }
        const unsigned old = xb_add(&bar[XB_XSUB(b.x)], 1u);
        const unsigned gen = old / nloc;
        if (old + 1u == (gen + 1u) * nloc) {
            __builtin_amdgcn_fence(__ATOMIC_RELEASE, "agent");
            asm volatile("s_waitcnt vmcnt(0)" ::: "memory");
            const unsigned og = xb_add(&bar[XB_TOP], 1u);
            const unsigned tg = og / nx;
            if (og + 1u == (tg + 1u) * nx) xb_add(&bar[XB_TOPGEN], 1u);
            else XB_SPIN(xb_ld(&bar[XB_TOPGEN]) == tg, bar);
            __builtin_amdgcn_fence(__ATOMIC_ACQUIRE, "agent");
            xb_add(&bar[XB_XGEN(b.x)], 1u);
            asm volatile("s_waitcnt vmcnt(0)" ::: "memory");
        } else {
            XB_SPIN(xb_ld(&bar[XB_XGEN(b.x)]) == gen, bar);
            __builtin_amdgcn_fence(__ATOMIC_ACQUIRE, "agent");
            asm volatile("s_waitcnt vmcnt(0)" ::: "memory");
        }
    }
    __syncthreads();
}


__device__ __forceinline__ int otid() { int t = threadIdx.x; asm volatile("" : "+v"(t)); return t; }
__device__ __forceinline__ float wave_sum(float v) {
#pragma unroll
    for (int o = 32; o > 0; o >>= 1) v += __shfl_xor(v, o, 64);
    return v;
}
__device__ __forceinline__ float gelu_tanh(float x) {
    const float u2 = 1.5957691216057308f * (x + 0.044715f * x * x * x);
    return x * __builtin_amdgcn_rcpf(1.f + __expf(-u2));
}
__device__ __forceinline__ float softplus_f(float z) { return fmaxf(z, 0.f) + log1pf(expf(-fabsf(z))); }
__device__ __forceinline__ float logsigmoid_f(float z) { return fminf(z, 0.f) - log1pf(expf(-fabsf(z))); }

typedef __attribute__((ext_vector_type(8))) short bf16x8;
typedef __attribute__((ext_vector_type(4))) short s16x4;
typedef __attribute__((ext_vector_type(16))) float f32x16;
typedef __attribute__((ext_vector_type(4))) unsigned u32x4;
typedef unsigned short bfu;
#define MFMA32(a, b, c) __builtin_amdgcn_mfma_f32_32x32x16_bf16((a), (b), (c), 0, 0, 0)
__device__ __forceinline__ unsigned pk2(float a, float b) {
    typedef __attribute__((ext_vector_type(2))) __bf16 bf2_t;
    typedef __attribute__((ext_vector_type(2))) float f2_t;
    f2_t v = {a, b};
    return __builtin_bit_cast(unsigned, __builtin_convertvector(v, bf2_t));
}
__device__ __forceinline__ bfu f2bf(float a) { return (bfu)(pk2(a, 0.f) & 0xffffu); }
__device__ __forceinline__ float bf2f(bfu b) { return __uint_as_float((unsigned)b << 16); }
__device__ __forceinline__ float bflo(unsigned u) { return __uint_as_float(u << 16); }
__device__ __forceinline__ float bfhi(unsigned u) { return __uint_as_float(u & 0xffff0000u); }
__device__ __forceinline__ int crow(int r, int hi) { return (r & 3) + 8 * (r >> 2) + 4 * hi; }
__device__ __forceinline__ size_t act_off(const size_t t, const int c) { return ((size_t)(c >> 5) * T_ + t) * 32 + (c & 31); }
constexpr float QSCALE_ = 0.125f * 1.4426950408889634f;
__device__ __forceinline__ void swap32(float x, float& lo, float& hi) {
    auto rr = __builtin_amdgcn_permlane32_swap(__float_as_uint(x), __float_as_uint(x), false, false);
    lo = __uint_as_float(rr[0]); hi = __uint_as_float(rr[1]);
}

template <bool REMAP>
__device__ __forceinline__ void d_transpose_w(const int vb, const float* __restrict__ w, bfu* __restrict__ wt, int ldw, int ntn, float* sm) {
    const int tn = vb % ntn, tk = vb / ntn, tid = otid();
    __syncthreads();
#pragma unroll
    for (int i = 0; i < 16; ++i) {
        const int k = i * 4 + (tid >> 6), n = tid & 63; int oc = tn * 64 + n; if (REMAP && oc >= 2688) oc += 12;
        sm[k * 65 + n] = w[(size_t)(tk * 64 + k) * ldw + oc];
    }
    __syncthreads();
#pragma unroll
    for (int i = 0; i < 16; ++i) {
        const int n = i * 4 + (tid >> 6), k = tid & 63;
        wt[((size_t)((tk * 64 + k) >> 5) * (ntn * 64) + tn * 64 + n) * 32 + (k & 31)] = f2bf(sm[k * 65 + n]);
    }
}

constexpr int GEMM_LDS = 73728;
struct UnitMap {
    int grp, NTT, NFT, tok_is_a;
    __device__ __forceinline__ void get(const int L, int& a0, int& b0) const {
        const int ttile = grp * NTT + (L / (8 * NFT)) * 8 + (L & 7), ftile = (L % (8 * NFT)) >> 3;
        if (tok_is_a) { a0 = ttile * 128; b0 = ftile * 256; } else { a0 = ftile * 128; b0 = ttile * 256; }
    }
};
struct OpLay { int rsA, ktsA, rsB, ktsB; };
typedef __attribute__((ext_vector_type(8))) int i32x8;
template <bool FP8, class Epi>
__device__ __forceinline__ void gemm_stream(const bfu* __restrict__ Ag, const bfu* __restrict__ Bg, char* lds, const Epi& epi, const UnitMap um, const OpLay ol, const int L0, const int step) {
    constexpr int K = D_, KT = FP8 ? K / 64 : K / 32, STG = 24576;
    const int total = um.NTT * um.NFT;
    if (L0 >= total) return;
    const int tid = otid(), lane = tid & 63, wid = __builtin_amdgcn_readfirstlane(tid >> 6), wa = wid >> 1, wb = wid & 1, r = lane & 31, h = lane >> 5;
    const int srow = tid >> 2, sch = (tid & 3) ^ ((srow >> 2) & 3);
    const size_t lane_offA = (size_t)srow * ol.rsA + sch * 8, lane_offB = (size_t)srow * ol.rsB + sch * 8;
#define GDMA(AP, BP, kt, buf) { _Pragma("unroll") for (int j = 0; j < 2; ++j) \
        __builtin_amdgcn_global_load_lds((const unsigned*)((AP) + (size_t)(64 * j) * ol.rsA + (size_t)(kt) * ol.ktsA), (LAS unsigned*)(lds + (buf) * STG + j * 4096 + tid * 16), 16, 0, 0); \
    _Pragma("unroll") for (int j = 0; j < 4; ++j) \
        __builtin_amdgcn_global_load_lds((const unsigned*)((BP) + (size_t)(64 * j) * ol.rsB + (size_t)(kt) * ol.ktsB), (LAS unsigned*)(lds + (buf) * STG + 8192 + j * 4096 + tid * 16), 16, 0, 0); }
    int L = L0, a0, b0;
    um.get(L, a0, b0);
    const bfu* ap = Ag + (size_t)a0 * ol.rsA + lane_offA;
    const bfu* bp = Bg + (size_t)b0 * ol.rsB + lane_offB;
    __syncthreads();
    GDMA(ap, bp, 0, 0); GDMA(ap, bp, 1, 1);
    const int sw = (r >> 2) & 3;
    const int aoff = (wa * 64 + r) * 64, boff = 8192 + (wb * 128 + r) * 64;
    int cur = 0, nxt2 = 2;
    asm volatile("s_waitcnt vmcnt(0)" ::: "memory");
    __builtin_amdgcn_s_barrier();
#pragma unroll 1
    for (;;) {
        const int Ln = L + step; const bool has_next = Ln < total;
        int a0n = a0, b0n = b0; if (has_next) um.get(Ln, a0n, b0n);
        const bfu* apn = Ag + (size_t)a0n * ol.rsA + lane_offA;
        const bfu* bpn = Bg + (size_t)b0n * ol.rsB + lane_offB;
        f32x16 acc[2][4];
#pragma unroll
        for (int i = 0; i < 2; ++i)
#pragma unroll
            for (int j = 0; j < 4; ++j)
#pragma unroll
                for (int e = 0; e < 16; ++e) acc[i][j][e] = 0.f;
#pragma unroll 1
        for (int kt = 0; kt < KT; ++kt) {
            const char* lb = lds + cur * STG;
            bf16x8 af[2][2], bf[2][4];
            {
                const int co = ((FP8 ? 2 * h : h) ^ sw) << 4;
#pragma unroll
                for (int i = 0; i < 2; ++i) af[0][i] = *(const bf16x8*)(lb + aoff + i * 2048 + co);
#pragma unroll
                for (int j = 0; j < 4; ++j) bf[0][j] = *(const bf16x8*)(lb + boff + j * 2048 + co);
            }
            if (!FP8) __builtin_amdgcn_sched_barrier(0);
            {
                const int co = ((FP8 ? 2 * h + 1 : 2 + h) ^ sw) << 4;
#pragma unroll
                for (int i = 0; i < 2; ++i) af[1][i] = *(const bf16x8*)(lb + aoff + i * 2048 + co);
#pragma unroll
                for (int j = 0; j < 4; ++j) bf[1][j] = *(const bf16x8*)(lb + boff + j * 2048 + co);
            }
            const bool in_unit = kt + 2 < KT;
            const bfu* apc = in_unit ? ap : apn; const bfu* bpc = in_unit ? bp : bpn;
            const int ktn = in_unit ? kt + 2 : (has_next ? kt + 2 - KT : KT - 1);
            if (FP8) __builtin_amdgcn_sched_barrier(0);
            GDMA(apc, bpc, ktn, nxt2);
            if (FP8) {
#pragma unroll
                for (int i = 0; i < 2; ++i)
#pragma unroll
                    for (int j = 0; j < 4; ++j) {
                        const i32x8 a8 = __builtin_bit_cast(i32x8, __builtin_shufflevector(af[0][i], af[1][i], 0, 1, 2, 3, 4, 5, 6, 7, 8, 9, 10, 11, 12, 13, 14, 15));
                        const i32x8 b8 = __builtin_bit_cast(i32x8, __builtin_shufflevector(bf[0][j], bf[1][j], 0, 1, 2, 3, 4, 5, 6, 7, 8, 9, 10, 11, 12, 13, 14, 15));
                        acc[i][j] = __builtin_amdgcn_mfma_scale_f32_32x32x64_f8f6f4(a8, b8, acc[i][j], 0, 0, 0, 0x7F7F7F7F, 0, 0x7F7F7F7F);
                    }
#pragma unroll
                for (int g = 0; g < 6; ++g) { __builtin_amdgcn_sched_group_barrier(0x010, 1, 0); __builtin_amdgcn_sched_group_barrier(0x008, 1, 0); }
                __builtin_amdgcn_sched_group_barrier(0x008, 2, 0);
            } else {
#pragma unroll
                for (int ks = 0; ks < 2; ++ks)
#pragma unroll
                    for (int i = 0; i < 2; ++i)
#pragma unroll
                        for (int j = 0; j < 4; ++j) acc[i][j] = MFMA32(af[ks][i], bf[ks][j], acc[i][j]);
#pragma unroll
                for (int g = 0; g < 6; ++g) { __builtin_amdgcn_sched_group_barrier(0x008, 1, 0); __builtin_amdgcn_sched_group_barrier(0x100, 1, 0); }
                __builtin_amdgcn_sched_group_barrier(0x008, 2, 0);
#pragma unroll
                for (int g = 0; g < 6; ++g) { __builtin_amdgcn_sched_group_barrier(0x010, 1, 0); __builtin_amdgcn_sched_group_barrier(0x008, 1, 0); }
                __builtin_amdgcn_sched_group_barrier(0x008, 2, 0);
            }
            __builtin_amdgcn_sched_barrier(0);
            if (kt + 1 < KT) { asm volatile("s_waitcnt vmcnt(6)" ::: "memory"); __builtin_amdgcn_s_barrier(); }
            cur = (cur == 2) ? 0 : cur + 1; nxt2 = (nxt2 == 2) ? 0 : nxt2 + 1;
        }
        asm volatile("s_waitcnt vmcnt(0)" ::: "memory");
        __builtin_amdgcn_s_barrier();
        epi(acc, a0 + wa * 64, b0 + wb * 128, r, h, lds + nxt2 * STG, wa, wb);
        if (!has_next) break;
        L = Ln; a0 = a0n; b0 = b0n; ap = apn; bp = bpn;
    }
    asm volatile("s_waitcnt vmcnt(0)" ::: "memory");
#undef GDMA
}
template <bool RES, bool REMAP>
struct EpiF32 {
    const float* R; float* C; int ldc;
    __device__ __forceinline__ void operator()(f32x16 (&acc)[2][4], int abase, int bbase, int r, int h, char* xl, int wa, int wb) const {
#pragma unroll
        for (int i = 0; i < 2; ++i)
#pragma unroll
            for (int j = 0; j < 4; ++j) {
                int col = bbase + j * 32 + r; if (REMAP && col >= 2688) col += 12;
#pragma unroll
                for (int e = 0; e < 16; ++e) {
                    const size_t o = (size_t)(abase + i * 32 + crow(e, h)) * ldc + col;
                    C[o] = acc[i][j][e] + (RES ? R[o] : 0.f);
                }
            }
    }
};

template <bool GATES>
__device__ __forceinline__ void d_rmsnorm(const int vb, const float* __restrict__ x, const float* __restrict__ g, bfu* __restrict__ out, unsigned char* __restrict__ out8,
                                          const float* swg, const float* __restrict__ ib, const float* __restrict__ fb, float* __restrict__ gi, float* __restrict__ glf) {
    const int row = vb * 4 + (otid() >> 6), lane = otid() & 63;
    const float4* xr = (const float4*)(x + (size_t)row * D_);
    const float4* g4 = (const float4*)g;
    float4 v[4]; float ss = 0.f;
#pragma unroll
    for (int i = 0; i < 4; ++i) { v[i] = xr[lane + 64 * i]; ss += v[i].x * v[i].x + v[i].y * v[i].y + v[i].z * v[i].z + v[i].w * v[i].w; }
    ss = wave_sum(ss);
    const float r = rsqrtf(ss * (1.f / D_) + EPS);
#pragma unroll
    for (int i = 0; i < 4; ++i) {
        const float4 gg = g4[lane + 64 * i];
        v[i].x *= r * gg.x; v[i].y *= r * gg.y; v[i].z *= r * gg.z; v[i].w *= r * gg.w;
        *(uint2*)(out + act_off(row, (lane + 64 * i) * 4)) = make_uint2(pk2(v[i].x, v[i].y), pk2(v[i].z, v[i].w));
        if (!GATES) {
            int w8 = __builtin_amdgcn_cvt_pk_fp8_f32(v[i].x, v[i].y, 0, false);
            w8 = __builtin_amdgcn_cvt_pk_fp8_f32(v[i].z, v[i].w, w8, true);
            const int col = (lane + 64 * i) * 4;
            *(int*)(out8 + ((size_t)(col >> 6) * T_ + row) * 64 + (col & 63)) = w8;
        }
    }
    if (GATES) {
        float mine = 0.f;
#pragma unroll
        for (int j = 0; j < 12; ++j) {
            float part = 0.f;
#pragma unroll
            for (int i = 0; i < 4; ++i) { const float4 w = *(const float4*)(swg + j * 1024 + (lane + 64 * i) * 4); part += v[i].x * w.x + v[i].y * w.y + v[i].z * w.z + v[i].w * w.w; }
            part = wave_sum(part);
            if (lane == j) mine = part;
        }
        const int b = row / S_, s = row % S_;
        if (lane < 6) gi[((size_t)b * 6 + lane) * S_ + s] = mine + ib[lane];
        else if (lane < 12) glf[((size_t)b * 6 + lane - 6) * S_ + s] = logsigmoid_f(mine + fb[lane - 6]);
    }
}
__device__ __forceinline__ void d_gatew(const int vb, const float* __restrict__ w_in, float* __restrict__ wg) {
    const int l = vb >> 2, k = (vb & 3) * 256 + otid();
    const float* src = w_in + ((size_t)l * D_ + k) * INW + ZMI;
    const float4 a = *(const float4*)src, b = *(const float4*)(src + 4), c = *(const float4*)(src + 8);
    const float v[12] = {a.x, a.y, a.z, a.w, b.x, b.y, b.z, b.w, c.x, c.y, c.z, c.w};
#pragma unroll
    for (int j = 0; j < 12; ++j) wg[((size_t)l * 12 + j) * 1024 + k] = v[j];
}

struct EpiBf16T {
    bfu* O; int ldo;
    __device__ __forceinline__ void operator()(f32x16 (&acc)[2][4], int abase, int bbase, int r, int h, char* xl, int wa, int wb) const {
#pragma unroll
        for (int j = 0; j < 4; ++j) {
            bfu* op = O + ((size_t)(abase >> 3) * T_ + (bbase + j * 32 + r)) * 8 + 4 * h;
#pragma unroll
            for (int i = 0; i < 2; ++i)
#pragma unroll
                for (int g = 0; g < 4; ++g)
                    *(uint2*)(op + (size_t)(4 * i + g) * T_ * 8) = make_uint2(pk2(acc[i][j][4 * g], acc[i][j][4 * g + 1]), pk2(acc[i][j][4 * g + 2], acc[i][j][4 * g + 3]));
        }
    }
};

struct EpiIn {
    const float* qg; const float* kg; const float* vng;
    bfu *sbq, *sbk, *sbv, *mlq, *mlk, *mlv, *mlo, *sgu, *sgv;
    __device__ __forceinline__ void operator()(f32x16 (&acc)[2][4], int abase, int bbase, int r, int h, char* xl, int wa, int wb) const {
        const int cb = __builtin_amdgcn_readfirstlane(abase >> 6);
#pragma unroll
        for (int j = 0; j < 4; ++j) {
            const int t = bbase + j * 32 + r, b = t >> 12, s = t & 4095;
            bfu* dst; float sc = 1.f; const float* gn = nullptr; size_t cst = (size_t)S_ * 8;
            if (cb < 6) { dst = sbq + (((size_t)b * 6 + cb) * 8 * S_ + s) * 8; gn = qg; sc = QSCALE_; }
            else if (cb < 12) { dst = sbk + (((size_t)b * 6 + cb - 6) * 8 * S_ + s) * 8; gn = kg; }
            else if (cb < 18) dst = sbv + (((size_t)b * 6 + cb - 12) * 8 * S_ + s) * 8;
            else if (cb < 24) dst = mlq + (((size_t)b * 6 + cb - 18) * 8 * S_ + s) * 8;
            else if (cb < 30) dst = mlk + (((size_t)b * 6 + cb - 24) * 8 * S_ + s) * 8;
            else if (cb < 36) dst = mlv + (((size_t)b * 6 + cb - 30) * 8 * S_ + s) * 8;
            else if (cb < 42) { dst = mlo + ((size_t)(cb - 36) * 8 * T_ + t) * 8; cst = (size_t)T_ * 8; }
            else if (cb < 46) { dst = sgu + ((size_t)(cb - 42) * 8 * T_ + t) * 8; cst = (size_t)T_ * 8; }
            else { dst = sgv + (((size_t)b * 4 + cb - 46) * 8 * S_ + s) * 8; gn = vng + (cb - 46) * 64; }
            if (cb >= 36 && cb < 42) {
#pragma unroll
                for (int i = 0; i < 2; ++i)
#pragma unroll
                    for (int e = 0; e < 16; ++e) acc[i][j][e] = __builtin_amdgcn_rcpf(1.f + __expf(-acc[i][j][e]));
            } else if (cb >= 42) {
#pragma unroll
                for (int i = 0; i < 2; ++i)
#pragma unroll
                    for (int e = 0; e < 16; ++e) acc[i][j][e] = gelu_tanh(acc[i][j][e]);
            }
            if (gn) {
                float ss = 0.f;
#pragma unroll
                for (int i = 0; i < 2; ++i)
#pragma unroll
                    for (int e = 0; e < 16; ++e) ss += acc[i][j][e] * acc[i][j][e];
                float lo, hi2; swap32(ss, lo, hi2);
                const float rinv = rsqrtf((lo + hi2) * (1.f / 64) + EPS) * sc;
#pragma unroll
                for (int i = 0; i < 2; ++i)
#pragma unroll
                    for (int g = 0; g < 4; ++g) {
                        const float4 g4 = *(const float4*)(gn + i * 32 + 8 * g + 4 * h);
                        acc[i][j][4 * g] *= rinv * g4.x; acc[i][j][4 * g + 1] *= rinv * g4.y; acc[i][j][4 * g + 2] *= rinv * g4.z; acc[i][j][4 * g + 3] *= rinv * g4.w;
                    }
            }
#pragma unroll
            for (int i = 0; i < 2; ++i)
#pragma unroll
                for (int g = 0; g < 4; ++g)
                    *(uint2*)(dst + (size_t)(4 * i + g) * cst + 4 * h) = make_uint2(pk2(acc[i][j][4 * g], acc[i][j][4 * g + 1]), pk2(acc[i][j][4 * g + 2], acc[i][j][4 * g + 3]));
        }
    }
};

__device__ __forceinline__ void d_cvt_bf16(const int vb, const float* __restrict__ src, bfu* __restrict__ dst) {
    const size_t e = (size_t)vb * 2048 + otid() * 8;
    const float4 a = *(const float4*)(src + e), b = *(const float4*)(src + e + 4);
    u32x4 o; o[0] = pk2(a.x, a.y); o[1] = pk2(a.z, a.w); o[2] = pk2(b.x, b.y); o[3] = pk2(b.z, b.w);
    *(u32x4*)(dst + e) = o;
}
typedef __attribute__((ext_vector_type(2))) __bf16 bf2_t;
__device__ __forceinline__ float dot2bf(unsigned a, unsigned b, float c) { return __builtin_amdgcn_fdot2_f32_bf16(__builtin_bit_cast(bf2_t, a), __builtin_bit_cast(bf2_t, b), c, false); }
__device__ __forceinline__ void d_peer_expert2(const int vb, const bfu* __restrict__ xn, const int* __restrict__ idx, const float* __restrict__ gate,
                                               const bfu* __restrict__ ut, const bfu* __restrict__ vt, float* x) {
    const int wv = __builtin_amdgcn_readfirstlane(otid() >> 6), lane = otid() & 63;
    const int t = vb * 4 + wv;
    const u32x4* xr = (const u32x4*)(xn + (size_t)t * D_);
    const u32x4 xp0 = xr[lane], xp1 = xr[lane + 64];
    float y[16];
#pragma unroll
    for (int i = 0; i < 16; ++i) y[i] = 0.f;
    const int* ip = idx + (size_t)t * 128; const float* gp = gate + (size_t)t * 128;
#pragma unroll 1
    for (int e0 = 0; e0 < 128; e0 += 8) {
        u32x4 u0[8], u1[8], v0[8], v1[8]; float a[8], g[8];
#pragma unroll
        for (int j = 0; j < 8; ++j) {
            const int id = ip[e0 + j]; g[j] = gp[e0 + j];
            const u32x4* ur = (const u32x4*)(ut + (size_t)id * D_); u0[j] = ur[lane]; u1[j] = ur[lane + 64];
            const u32x4* vr = (const u32x4*)(vt + (size_t)id * D_); v0[j] = vr[lane]; v1[j] = vr[lane + 64];
        }
#pragma unroll
        for (int j = 0; j < 8; ++j) {
            float acc = 0.f;
#pragma unroll
            for (int q = 0; q < 4; ++q) { acc = dot2bf(u0[j][q], xp0[q], acc); acc = dot2bf(u1[j][q], xp1[q], acc); }
            a[j] = acc;
        }
#pragma unroll
        for (int j = 0; j < 8; ++j) a[j] = wave_sum(a[j]);
#pragma unroll
        for (int j = 0; j < 8; ++j) {
            const float w = gelu_tanh(a[j]) * g[j];
#pragma unroll
            for (int q = 0; q < 4; ++q) {
                y[2 * q] += w * bflo(v0[j][q]); y[2 * q + 1] += w * bfhi(v0[j][q]);
                y[8 + 2 * q] += w * bflo(v1[j][q]); y[8 + 2 * q + 1] += w * bfhi(v1[j][q]);
            }
        }
    }
    float4* xo = (float4*)(x + (size_t)t * D_);
#pragma unroll
    for (int i = 0; i < 2; ++i) {
        float4 r0 = xo[lane * 2 + 128 * i], r1 = xo[lane * 2 + 128 * i + 1];
        r0.x += y[8 * i]; r0.y += y[8 * i + 1]; r0.z += y[8 * i + 2]; r0.w += y[8 * i + 3];
        r1.x += y[8 * i + 4]; r1.y += y[8 * i + 5]; r1.z += y[8 * i + 6]; r1.w += y[8 * i + 7];
        xo[lane * 2 + 128 * i] = r0; xo[lane * 2 + 128 * i + 1] = r1;
    }
}

__device__ __forceinline__ void d_cvt_fp8(const int vb, const float* __restrict__ src, unsigned char* __restrict__ dst, float* __restrict__ inv_scale) {
    const int tid = otid(), lane = tid & 63, row = vb * 4 + (tid >> 6);
    const float4* sr = (const float4*)(src + (size_t)row * D_);
    float4 v[4]; float am = 0.f;
#pragma unroll
    for (int i = 0; i < 4; ++i) { v[i] = sr[lane + 64 * i]; am = fmaxf(am, fmaxf(fmaxf(fabsf(v[i].x), fabsf(v[i].y)), fmaxf(fabsf(v[i].z), fabsf(v[i].w)))); }
#pragma unroll
    for (int o = 32; o > 0; o >>= 1) am = fmaxf(am, __shfl_xor(am, o, 64));
    const float sc = am > 0.f ? 256.f / am : 1.f;
    if (lane == 0) inv_scale[row] = am > 0.f ? am * (1.f / 256.f) : 1.f;
    unsigned* dr = (unsigned*)(dst + (size_t)row * D_);
#pragma unroll
    for (int i = 0; i < 4; ++i) {
        int w = 0;
        w = __builtin_amdgcn_cvt_pk_fp8_f32(v[i].x * sc, v[i].y * sc, w, false);
        w = __builtin_amdgcn_cvt_pk_fp8_f32(v[i].z * sc, v[i].w * sc, w, true);
        dr[lane + 64 * i] = (unsigned)w;
    }
}
typedef __attribute__((ext_vector_type(2))) float f2_t;
__device__ __forceinline__ void d_peer_expert3(const int vb, const bfu* __restrict__ xn, const int* __restrict__ idx, const float* __restrict__ gate,
                                               const unsigned char* __restrict__ ut, const unsigned char* __restrict__ vt, const float* __restrict__ usc, const float* __restrict__ vsc, float* x) {
    const int tid = otid(), lane = tid & 63;
    const int wv = __builtin_amdgcn_readfirstlane(tid >> 6);
    const int t = vb * 4 + wv;
    float xv[16], y[16];
    {
        const u32x4* xr = (const u32x4*)(xn + act_off(t, lane * 16));
        const u32x4 a = xr[0], b = xr[1];
#pragma unroll
        for (int q = 0; q < 4; ++q) { xv[2 * q] = bflo(a[q]); xv[2 * q + 1] = bfhi(a[q]); xv[8 + 2 * q] = bflo(b[q]); xv[8 + 2 * q + 1] = bfhi(b[q]); }
    }
#pragma unroll
    for (int i = 0; i < 16; ++i) y[i] = 0.f;
    const int* ip = idx + (size_t)t * 128; const float* gp = gate + (size_t)t * 128;
#pragma unroll 1
    for (int e0 = 0; e0 < 128; e0 += 16) {
        u32x4 u[16], v[16]; float a[16], g[16];
#pragma unroll
        for (int j = 0; j < 16; ++j) {
            const int id = ip[e0 + j];
            u[j] = *(const u32x4*)(ut + (size_t)id * D_ + lane * 16);
            v[j] = *(const u32x4*)(vt + (size_t)id * D_ + lane * 16);
            a[j] = usc[id]; g[j] = gp[e0 + j] * vsc[id];
        }
#pragma unroll
        for (int j = 0; j < 16; ++j) {
            float acc = 0.f;
#pragma unroll
            for (int q = 0; q < 4; ++q) {
                const f2_t lo = __builtin_amdgcn_cvt_pk_f32_fp8((int)u[j][q], false), hi = __builtin_amdgcn_cvt_pk_f32_fp8((int)u[j][q], true);
                acc += lo[0] * xv[4 * q] + lo[1] * xv[4 * q + 1] + hi[0] * xv[4 * q + 2] + hi[1] * xv[4 * q + 3];
            }
            a[j] *= wave_sum(acc);
        }
#pragma unroll
        for (int j = 0; j < 16; ++j) {
            const float w = gelu_tanh(a[j]) * g[j];
#pragma unroll
            for (int q = 0; q < 4; ++q) {
                const f2_t lo = __builtin_amdgcn_cvt_pk_f32_fp8((int)v[j][q], false), hi = __builtin_amdgcn_cvt_pk_f32_fp8((int)v[j][q], true);
                y[4 * q] += w * lo[0]; y[4 * q + 1] += w * lo[1]; y[4 * q + 2] += w * hi[0]; y[4 * q + 3] += w * hi[1];
            }
        }
    }
    float4* xo = (float4*)(x + (size_t)t * D_ + lane * 16);
#pragma unroll
    for (int i = 0; i < 4; ++i) { float4 r0 = xo[i]; r0.x += y[4 * i]; r0.y += y[4 * i + 1]; r0.z += y[4 * i + 2]; r0.w += y[4 * i + 3]; xo[i] = r0; }
}

template <int CTRL> __device__ __forceinline__ float dpp_f(float x) { return __int_as_float(__builtin_amdgcn_update_dpp(0, __float_as_int(x), CTRL, 0xF, 0xF, true)); }
__device__ __forceinline__ float row16_allreduce(float x) {
    x += dpp_f<0xB1>(x); x += dpp_f<0x4E>(x); x += dpp_f<0x124>(x); x += dpp_f<0x128>(x); return x;
}
__device__ __forceinline__ void d_peer_expert4(const int vb, const bfu* __restrict__ xn, const int* __restrict__ idx, const float* __restrict__ gate,
                                               const unsigned char* __restrict__ ut, const unsigned char* __restrict__ vt, const float* __restrict__ usc, const float* __restrict__ vsc, float* x) {
    const int tid = otid(), lane = tid & 63;
    const int wv = __builtin_amdgcn_readfirstlane(tid >> 6);
    const int t = vb * 4 + wv;
    float xv[16], y[16];
    {
        const u32x4* xr = (const u32x4*)(xn + act_off(t, lane * 16));
        const u32x4 a = xr[0], b = xr[1];
#pragma unroll
        for (int q = 0; q < 4; ++q) { xv[2 * q] = bflo(a[q]); xv[2 * q + 1] = bfhi(a[q]); xv[8 + 2 * q] = bflo(b[q]); xv[8 + 2 * q + 1] = bfhi(b[q]); }
    }
#pragma unroll
    for (int i = 0; i < 16; ++i) y[i] = 0.f;
    const int* ip = idx + (size_t)t * 128; const float* gp = gate + (size_t)t * 128;
    const int sel = (lane >> 2) & 3;
    const int el = ((lane >> 5) & 1) * 8 + ((lane >> 4) & 1) * 4 + sel;
#pragma unroll 1
    for (int e0 = 0; e0 < 128; e0 += 16) {
        u32x4 u[16], v[16];
#pragma unroll
        for (int j = 0; j < 16; ++j) {
            const int id = ip[e0 + j];
            u[j] = *(const u32x4*)(ut + (size_t)id * D_ + lane * 16);
            v[j] = *(const u32x4*)(vt + (size_t)id * D_ + lane * 16);
        }
        const int myid = ip[e0 + el];
        const float myus = usc[myid], mygs = gp[e0 + el] * vsc[myid];
        float pd[16];
#pragma unroll
        for (int j = 0; j < 16; ++j) {
            float acc = 0.f;
#pragma unroll
            for (int q = 0; q < 4; ++q) {
                const f2_t lo = __builtin_amdgcn_cvt_pk_f32_fp8((int)u[j][q], false), hi = __builtin_amdgcn_cvt_pk_f32_fp8((int)u[j][q], true);
                acc += lo[0] * xv[4 * q] + lo[1] * xv[4 * q + 1] + hi[0] * xv[4 * q + 2] + hi[1] * xv[4 * q + 3];
            }
            pd[j] = acc;
        }
        float q8[8], q4[4];
#pragma unroll
        for (int i = 0; i < 8; ++i) { auto rr = __builtin_amdgcn_permlane32_swap(__float_as_uint(pd[i]), __float_as_uint(pd[i + 8]), false, false); q8[i] = __uint_as_float(rr[0]) + __uint_as_float(rr[1]); }
#pragma unroll
        for (int i = 0; i < 4; ++i) { auto rr = __builtin_amdgcn_permlane16_swap(__float_as_uint(q8[i]), __float_as_uint(q8[i + 4]), false, false); q4[i] = row16_allreduce(__uint_as_float(rr[0]) + __uint_as_float(rr[1])); }
        const float s = sel == 0 ? q4[0] : sel == 1 ? q4[1] : sel == 2 ? q4[2] : q4[3];
        const float w = gelu_tanh(s * myus) * mygs;
#pragma unroll
        for (int j = 0; j < 16; ++j) {
            const float wj = __int_as_float(__builtin_amdgcn_readlane(__float_as_int(w), ((j >> 3) & 1) * 32 + ((j >> 2) & 1) * 16 + (j & 3) * 4));
#pragma unroll
            for (int q = 0; q < 4; ++q) {
                const f2_t lo = __builtin_amdgcn_cvt_pk_f32_fp8((int)v[j][q], false), hi = __builtin_amdgcn_cvt_pk_f32_fp8((int)v[j][q], true);
                y[4 * q] += wj * lo[0]; y[4 * q + 1] += wj * lo[1]; y[4 * q + 2] += wj * hi[0]; y[4 * q + 3] += wj * hi[1];
            }
        }
    }
    float4* xo = (float4*)(x + (size_t)t * D_ + lane * 16);
#pragma unroll
    for (int i = 0; i < 4; ++i) { float4 r0 = xo[i]; r0.x += y[4 * i]; r0.y += y[4 * i + 1]; r0.z += y[4 * i + 2]; r0.w += y[4 * i + 3]; xo[i] = r0; }
}

__device__ __forceinline__ void d_cvt_i4(const int vb, const float* __restrict__ src, unsigned char* __restrict__ dst  , float* __restrict__ step) {
    const int tid = otid(), lane = tid & 63, row = vb * 4 + (tid >> 6);
    const float4* sr = (const float4*)(src + (size_t)row * D_ + lane * 16);
    float v[16]; float am = 0.f, ss = 0.f;
#pragma unroll
    for (int i = 0; i < 4; ++i) { const float4 a = sr[i]; v[4 * i] = a.x; v[4 * i + 1] = a.y; v[4 * i + 2] = a.z; v[4 * i + 3] = a.w; }
#pragma unroll
    for (int i = 0; i < 16; ++i) { am = fmaxf(am, fabsf(v[i])); ss += v[i] * v[i]; }
    ss = wave_sum(ss);
#pragma unroll
    for (int o = 32; o > 0; o >>= 1) am = fmaxf(am, __shfl_xor(am, o, 64));
    float s = fmaxf(2.5f * sqrtf(ss * (1.f / D_)), am * (1.f / 16.f)) * (1.f / 7.f);
    if (!(s > 0.f)) s = 1.f;
    const float inv = 1.f / s;
    if (lane == 0) step[row] = s;
    unsigned w[2];
#pragma unroll
    for (int d = 0; d < 2; ++d) {
        unsigned acc = 0u;
#pragma unroll
        for (int e = 0; e < 8; ++e) {
            const int q = (int)fminf(fmaxf(rintf(v[8 * d + e] * inv), -8.f), 7.f);
            acc |= (unsigned)((e < 4) ? (q + 8) : (q & 15)) << ((e & 3) * 8 + (e >> 2) * 4);
        }
        w[d] = acc;
    }
    *(uint2*)(dst + (size_t)row * 1024 + lane * 16) = make_uint2(w[0], w[1]);
}
template <bool UENC>
__device__ __forceinline__ void d_cvt_i4x2(const int vb, const float* __restrict__ src, unsigned char* __restrict__ dst, float* __restrict__ step) {
    const int tid = otid(), lane = tid & 63, row0 = vb * 8 + (tid >> 6) * 2;
    float v[2][16];
#pragma unroll
    for (int rr = 0; rr < 2; ++rr) {
        const float4* sr = (const float4*)(src + (size_t)(row0 + rr) * D_ + lane * 16);
#pragma unroll
        for (int i = 0; i < 4; ++i) { const float4 a = sr[i]; v[rr][4 * i] = a.x; v[rr][4 * i + 1] = a.y; v[rr][4 * i + 2] = a.z; v[rr][4 * i + 3] = a.w; }
    }
#pragma unroll
    for (int rr = 0; rr < 2; ++rr) {
        float am = 0.f, ss = 0.f;
#pragma unroll
        for (int i = 0; i < 16; ++i) { am = fmaxf(am, fabsf(v[rr][i])); ss += v[rr][i] * v[rr][i]; }
        ss = wave_sum(ss);
#pragma unroll
        for (int o = 32; o > 0; o >>= 1) am = fmaxf(am, __shfl_xor(am, o, 64));
        float s = fmaxf(2.5f * sqrtf(ss * (1.f / D_)), am * (1.f / 16.f)) * (1.f / 7.f);
        if (!(s > 0.f)) s = 1.f;
        const float inv = 1.f / s;
        if (lane == 0) step[row0 + rr] = s;
        unsigned w[2];
#pragma unroll
        for (int d = 0; d < 2; ++d) {
            unsigned acc = 0u;
#pragma unroll
            for (int e = 0; e < 8; ++e) {
                const int q = (int)fminf(fmaxf(rintf(v[rr][8 * d + e] * inv), -8.f), 7.f);
                if (UENC) acc |= (unsigned)(q & 15) << (4 * e);
                else acc |= (unsigned)((e < 4) ? (q + 8) : (q & 15)) << ((e & 3) * 8 + (e >> 2) * 4);
            }
            w[d] = acc;
        }
        *(uint2*)(dst + (size_t)(row0 + rr) * 1024 + lane * 16) = make_uint2(w[0], w[1]);
    }
}
__device__ __forceinline__ float ub0(unsigned w) { float r; asm("v_cvt_f32_ubyte0 %0, %1" : "=v"(r) : "v"(w)); return r; }
__device__ __forceinline__ float ub1(unsigned w) { float r; asm("v_cvt_f32_ubyte1 %0, %1" : "=v"(r) : "v"(w)); return r; }
__device__ __forceinline__ float ub2(unsigned w) { float r; asm("v_cvt_f32_ubyte2 %0, %1" : "=v"(r) : "v"(w)); return r; }
__device__ __forceinline__ float ub3(unsigned w) { float r; asm("v_cvt_f32_ubyte3 %0, %1" : "=v"(r) : "v"(w)); return r; }
template <int CTRL> __device__ __forceinline__ int dpp_i(int x) { return __builtin_amdgcn_update_dpp(0, x, CTRL, 0xF, 0xF, true); }
__device__ __forceinline__ int transpose_reduce16(const int (&pd)[16], const int sel) {
    int q8[8], q4[4];
#pragma unroll
    for (int i = 0; i < 8; ++i) { auto rr = __builtin_amdgcn_permlane32_swap((unsigned)pd[i], (unsigned)pd[i + 8], false, false); q8[i] = (int)rr[0] + (int)rr[1]; }
#pragma unroll
    for (int i = 0; i < 4; ++i) {
        auto rr = __builtin_amdgcn_permlane16_swap((unsigned)q8[i], (unsigned)q8[i + 4], false, false);
        int x = (int)rr[0] + (int)rr[1];
        x += dpp_i<0xB1>(x); x += dpp_i<0x4E>(x); x += dpp_i<0x124>(x); x += dpp_i<0x128>(x);
        q4[i] = x;
    }
    return sel == 0 ? q4[0] : sel == 1 ? q4[1] : sel == 2 ? q4[2] : q4[3];
}
template <bool FUSE_NORM>
__device__ __forceinline__ void d_peer_expert5(const int vb, bfu* xn, const int* __restrict__ idx, const float* __restrict__ gate,
                                               const unsigned char* __restrict__ ut, const unsigned char* __restrict__ vt, const float* __restrict__ usc, const float* __restrict__ vsc, float* x,
                                               const float* __restrict__ g1n, const float* swg, const float* __restrict__ ib, const float* __restrict__ fb, float* __restrict__ gi, float* __restrict__ glf) {
    const int tid = otid(), lane = tid & 63;
    const int wv = __builtin_amdgcn_readfirstlane(tid >> 6);
    const int t = vb * 4 + wv;
    int xh[2], xl[2]; float xs;
    {
        float xv[16];
        const u32x4* xr = (const u32x4*)(xn + act_off(t, lane * 16));
        const u32x4 a = xr[0], b = xr[1];
#pragma unroll
        for (int q = 0; q < 4; ++q) { xv[2 * q] = bflo(a[q]); xv[2 * q + 1] = bfhi(a[q]); xv[8 + 2 * q] = bflo(b[q]); xv[8 + 2 * q + 1] = bfhi(b[q]); }
        float am = 0.f;
#pragma unroll
        for (int i = 0; i < 16; ++i) am = fmaxf(am, fabsf(xv[i]));
#pragma unroll
        for (int o = 32; o > 0; o >>= 1) am = fmaxf(am, __shfl_xor(am, o, 64));
        xs = am > 0.f ? am * (1.f / 119.f) : 1.f;
        const float inv = 1.f / xs;
#pragma unroll
        for (int d = 0; d < 2; ++d) {
            unsigned ah = 0u, al = 0u;
#pragma unroll
            for (int e = 0; e < 8; ++e) {
                const int q = (int)rintf(xv[8 * d + e] * inv);
                const int lo4 = ((q + 8) & 15) - 8, hi4 = (q - lo4) >> 4;
                ah |= (unsigned)(hi4 & 15) << (4 * e); al |= (unsigned)(lo4 & 15) << (4 * e);
            }
            xh[d] = (int)ah; xl[d] = (int)al;
        }
    }
    float y[16];
#pragma unroll
    for (int i = 0; i < 16; ++i) y[i] = 0.f;
    const int* ip = idx + (size_t)t * 128; const float* gp = gate + (size_t)t * 128;
    const int sel = (lane >> 2) & 3;
    const int el = ((lane >> 5) & 1) * 8 + ((lane >> 4) & 1) * 4 + sel;
#pragma unroll 1
    for (int e0 = 0; e0 < 128; e0 += 32) {
        uint2 u[32], v[32];
#pragma unroll
        for (int j = 0; j < 32; ++j) {
            const int id = ip[e0 + j];
            const u32x4 uv = *(const u32x4*)(ut + (size_t)id * 1024 + lane * 16);
            u[j] = make_uint2(uv[0], uv[1]); v[j] = make_uint2(uv[2], uv[3]);
        }
        const int myid0 = ip[e0 + el], myid1 = ip[e0 + 16 + el];
        const float us0 = usc[myid0] * xs, us1 = usc[myid1] * xs, gs0 = gp[e0 + el] * vsc[myid0], gs1 = gp[e0 + 16 + el] * vsc[myid1];
        float w0, w1;
        {
            int pd[16];
#pragma unroll
            for (int j = 0; j < 16; ++j) {
                int acch = __builtin_amdgcn_sdot8((int)u[j].x, xh[0], 0, false);
                acch = __builtin_amdgcn_sdot8((int)u[j].y, xh[1], acch, false);
                int accl = __builtin_amdgcn_sdot8((int)u[j].x, xl[0], 0, false);
                accl = __builtin_amdgcn_sdot8((int)u[j].y, xl[1], accl, false);
                pd[j] = (acch << 4) + accl;
            }
            w0 = gelu_tanh((float)transpose_reduce16(pd, sel) * us0) * gs0;
#pragma unroll
            for (int j = 0; j < 16; ++j) {
                int acch = __builtin_amdgcn_sdot8((int)u[16 + j].x, xh[0], 0, false);
                acch = __builtin_amdgcn_sdot8((int)u[16 + j].y, xh[1], acch, false);
                int accl = __builtin_amdgcn_sdot8((int)u[16 + j].x, xl[0], 0, false);
                accl = __builtin_amdgcn_sdot8((int)u[16 + j].y, xl[1], accl, false);
                pd[j] = (acch << 4) + accl;
            }
            w1 = gelu_tanh((float)transpose_reduce16(pd, sel) * us1) * gs1;
        }
        float wam = fmaxf(fabsf(w0), fabsf(w1));
#pragma unroll
        for (int o = 32; o > 0; o >>= 1) wam = fmaxf(wam, __shfl_xor(wam, o, 64));
        const float wsc = wam > 0.f ? wam * (1.f / 127.f) : 1.f, winv = 1.f / wsc;
        const int wq0 = (int)rintf(w0 * winv), wq1 = (int)rintf(w1 * winv);
        unsigned wpk[8]; int swq = 0;
#pragma unroll
        for (int g = 0; g < 8; ++g) {
            int bq[4];
#pragma unroll
            for (int i = 0; i < 4; ++i) {
                const int j = 4 * g + i, jj = j & 15;
                bq[i] = __builtin_amdgcn_readlane(j < 16 ? wq0 : wq1, ((jj >> 3) & 1) * 32 + ((jj >> 2) & 1) * 16 + (jj & 3) * 4);
                swq += bq[i];
            }
            wpk[g] = (unsigned)(bq[0] & 255) | ((unsigned)(bq[1] & 255) << 8) | ((unsigned)(bq[2] & 255) << 16) | ((unsigned)bq[3] << 24);
        }
        int a1[8], a2[8];
#pragma unroll
        for (int e = 0; e < 8; ++e) { a1[e] = -8 * swq; a2[e] = 0; }
#pragma unroll
        for (int g = 0; g < 8; ++g) {
#pragma unroll
            for (int s = 0; s < 2; ++s) {
                unsigned q[4];
#pragma unroll
                for (int i = 0; i < 4; ++i) q[i] = s ? v[4 * g + i].y : v[4 * g + i].x;
                const unsigned p0 = __builtin_amdgcn_perm(q[1], q[0], 0x05010400u), p1 = __builtin_amdgcn_perm(q[1], q[0], 0x07030602u);
                const unsigned p2 = __builtin_amdgcn_perm(q[3], q[2], 0x05010400u), p3 = __builtin_amdgcn_perm(q[3], q[2], 0x07030602u);
                const unsigned t0 = __builtin_amdgcn_perm(p2, p0, 0x05040100u), t1 = __builtin_amdgcn_perm(p2, p0, 0x07060302u);
                const unsigned t2 = __builtin_amdgcn_perm(p3, p1, 0x05040100u), t3 = __builtin_amdgcn_perm(p3, p1, 0x07060302u);
                a1[4 * s] = __builtin_amdgcn_sdot4((int)t0, (int)wpk[g], a1[4 * s], false);
                a1[4 * s + 1] = __builtin_amdgcn_sdot4((int)t1, (int)wpk[g], a1[4 * s + 1], false);
                a1[4 * s + 2] = __builtin_amdgcn_sdot4((int)t2, (int)wpk[g], a1[4 * s + 2], false);
                a1[4 * s + 3] = __builtin_amdgcn_sdot4((int)t3, (int)wpk[g], a1[4 * s + 3], false);
                a2[4 * s] = __builtin_amdgcn_sdot4((int)(t0 & 0xF0F0F0F0u), (int)wpk[g], a2[4 * s], false);
                a2[4 * s + 1] = __builtin_amdgcn_sdot4((int)(t1 & 0xF0F0F0F0u), (int)wpk[g], a2[4 * s + 1], false);
                a2[4 * s + 2] = __builtin_amdgcn_sdot4((int)(t2 & 0xF0F0F0F0u), (int)wpk[g], a2[4 * s + 2], false);
                a2[4 * s + 3] = __builtin_amdgcn_sdot4((int)(t3 & 0xF0F0F0F0u), (int)wpk[g], a2[4 * s + 3], false);
            }
        }
        int yi[16];
#pragma unroll
        for (int s = 0; s < 2; ++s)
#pragma unroll
            for (int e = 0; e < 4; ++e) { yi[8 * s + e] = a1[4 * s + e] - a2[4 * s + e]; yi[8 * s + e + 4] = a2[4 * s + e] >> 4; }
#pragma unroll
        for (int e = 0; e < 16; ++e) y[e] += wsc * (float)yi[e];
    }
    float4* xo = (float4*)(x + (size_t)t * D_ + lane * 16);
    float ss = 0.f;
#pragma unroll
    for (int i = 0; i < 4; ++i) {
        float4 r0 = xo[i]; r0.x += y[4 * i]; r0.y += y[4 * i + 1]; r0.z += y[4 * i + 2]; r0.w += y[4 * i + 3]; xo[i] = r0;
        y[4 * i] = r0.x; y[4 * i + 1] = r0.y; y[4 * i + 2] = r0.z; y[4 * i + 3] = r0.w;
        ss += r0.x * r0.x + r0.y * r0.y + r0.z * r0.z + r0.w * r0.w;
    }
    if (FUSE_NORM) {
        ss = wave_sum(ss);
        const float rn = rsqrtf(ss * (1.f / D_) + EPS);
#pragma unroll
        for (int i = 0; i < 4; ++i) { const float4 gg = *(const float4*)(g1n + lane * 16 + 4 * i); y[4 * i] *= rn * gg.x; y[4 * i + 1] *= rn * gg.y; y[4 * i + 2] *= rn * gg.z; y[4 * i + 3] *= rn * gg.w; }
        u32x4 o0, o1;
#pragma unroll
        for (int i = 0; i < 4; ++i) { o0[i] = pk2(y[2 * i], y[2 * i + 1]); o1[i] = pk2(y[8 + 2 * i], y[8 + 2 * i + 1]); }
        u32x4* xw = (u32x4*)(xn + act_off(t, lane * 16));
        xw[0] = o0; xw[1] = o1;
        float mine = 0.f;
#pragma unroll
        for (int j = 0; j < 12; ++j) {
            float part = 0.f;
#pragma unroll
            for (int i = 0; i < 4; ++i) { const float4 w4 = *(const float4*)(swg + j * 1024 + lane * 16 + 4 * i); part += y[4 * i] * w4.x + y[4 * i + 1] * w4.y + y[4 * i + 2] * w4.z + y[4 * i + 3] * w4.w; }
            part = wave_sum(part);
            if (lane == j) mine = part;
        }
        const int b = t / S_, s = t % S_;
        if (lane < 6) gi[((size_t)b * 6 + lane) * S_ + s] = mine + ib[lane];
        else if (lane < 12) glf[((size_t)b * 6 + lane - 6) * S_ + s] = logsigmoid_f(mine + fb[lane - 6]);
    }
}

typedef short v4i16_t __attribute__((ext_vector_type(4)));
__device__ __forceinline__ s16x4 vtr(const char* p) { return __builtin_bit_cast(s16x4, __builtin_amdgcn_ds_read_tr16_b64_v4i16((LAS v4i16_t*)p)); }
__device__ __forceinline__ void sb_subtile(const f32x16& p, const int keybase, const int qg, const bool diag, const int h, float& carry, bf16x8& f0, bf16x8& f1) {
    float bt[16], rr[16];
#pragma unroll
    for (int e = 0; e < 16; ++e) {
        float pe = fminf(p[e], 120.f);
        if (diag) { const int key = keybase + (e & 3) + 8 * (e >> 2); if (key >= qg) pe = -INFINITY; }
        const float t = __builtin_amdgcn_exp2f(pe);
        const float r = __builtin_amdgcn_rcpf(1.f + t);
        bt[e] = t * r; rr[e] = r;
    }
    float lo[4], hi[4];
#pragma unroll
    for (int g = 0; g < 4; ++g) swap32((rr[4 * g] * rr[4 * g + 1]) * (rr[4 * g + 2] * rr[4 * g + 3]), lo[g], hi[g]);
    float T[8];
    T[7] = 1.f; T[6] = hi[3]; T[5] = T[6] * lo[3]; T[4] = T[5] * hi[2]; T[3] = T[4] * lo[2]; T[2] = T[3] * hi[1]; T[1] = T[2] * lo[1]; T[0] = T[1] * hi[0];
    const float total = T[0] * lo[0];
    float w[16];
#pragma unroll
    for (int g = 0; g < 4; ++g) {
        float c = carry * (h ? T[2 * g + 1] : T[2 * g]);
#pragma unroll
        for (int i = 3; i >= 0; --i) {
            const int e = 4 * g + i;
            w[e] = bt[e] * c;
            c *= rr[e];
        }
    }
    carry *= total;
    u32x4 a, b;
#pragma unroll
    for (int i = 0; i < 4; ++i) { a[i] = pk2(w[2 * i], w[2 * i + 1]); b[i] = pk2(w[8 + 2 * i], w[8 + 2 * i + 1]); }
    f0 = __builtin_bit_cast(bf16x8, a); f1 = __builtin_bit_cast(bf16x8, b);
}
constexpr int SBA_LDS = 32768;
__device__ __forceinline__ void d_sb_attn2(const int unit, const bfu* __restrict__ Qs, const bfu* __restrict__ Ks, const bfu* __restrict__ Vs,
                                           const float* __restrict__ og, bfu* __restrict__ y, char* lds) {
    const int qb = 31 - unit / 48, bh = unit % 48, b = bh / 6, hh = bh % 6;
    const int tid = otid(), lane = tid & 63, r = lane & 31, h = lane >> 5;
    const int wid = __builtin_amdgcn_readfirstlane(tid >> 6);
    const bfu* Kg = Ks + (size_t)bh * S_ * 64; const bfu* Vg = Vs + (size_t)bh * S_ * 64;
    const int q0 = qb * 128 + wid * 32, qg = q0 + r;
    bf16x8 qf[4];
#pragma unroll
    for (int ks = 0; ks < 4; ++ks) qf[ks] = *(const bf16x8*)(Qs + (size_t)bh * S_ * 64 + ((size_t)(2 * ks + h) * S_ + qg) * 8);
    f32x16 o0, o1;
#pragma unroll
    for (int e = 0; e < 16; ++e) { o0[e] = 0.f; o1[e] = 0.f; }
    float carry = 1.f;
    const int nt = 2 * qb + 2;
    const int srow = tid >> 3, sch = tid & 7;
    const int koff = srow * 128 + ((sch ^ (srow & 7)) << 4), voff = 8192 + (sch >> 2) * 4096 + srow * 64 + (sch & 3) * 16;
    u32x4 sk0, sk1, sv0, sv1;
#define GLOAD(kt) { const size_t gb = ((size_t)sch * S_ + (kt) * 64 + srow) * 8; sk0 = *(const u32x4*)(Kg + gb); sk1 = *(const u32x4*)(Kg + gb + 256); sv0 = *(const u32x4*)(Vg + gb); sv1 = *(const u32x4*)(Vg + gb + 256); }
#define LSTORE(buf) { char* bb = lds + (buf) * 16384; *(u32x4*)(bb + koff) = sk0; *(u32x4*)(bb + koff + 4096) = sk1; *(u32x4*)(bb + voff) = sv0; *(u32x4*)(bb + voff + 2048) = sv1; }
    __syncthreads();
    GLOAD(nt - 1); LSTORE(0);
    __syncthreads();
    const int kro = r * 128, sw = r & 7;
    volatile int* sflag = (volatile int*)(lds + SBA_LDS);
    const int vlane = 8192 + ((lane >> 4) & 1) * 32 + (lane & 3) * 8 + (4 * h + ((lane & 15) >> 2)) * 64;
#pragma unroll 1
    for (int it = 0; it < nt; ++it) {
        const int kt = nt - 1 - it;
        if (it + 1 < nt) GLOAD(kt - 1);
        const char* kb_ = lds + (it & 1) * 16384;
        f32x16 p0, p1;
#pragma unroll
        for (int e = 0; e < 16; ++e) { p0[e] = 0.f; p1[e] = 0.f; }
#pragma unroll
        for (int ks = 0; ks < 4; ++ks) {
            const int co = ((2 * ks + h) ^ sw) << 4;
            const bf16x8 k0 = *(const bf16x8*)(kb_ + kro + co), k1 = *(const bf16x8*)(kb_ + kro + 4096 + co);
            p0 = MFMA32(k0, qf[ks], p0); p1 = MFMA32(k1, qf[ks], p1);
        }
        const bool diag = kt >= 2 * qb;
        bf16x8 pf[4];
        sb_subtile(p1, kt * 64 + 32 + 4 * h, qg, diag, h, carry, pf[2], pf[3]);
        sb_subtile(p0, kt * 64 + 4 * h, qg, diag, h, carry, pf[0], pf[1]);
#pragma unroll
        for (int kk = 0; kk < 4; ++kk) {
            const char* vp = kb_ + vlane + kk * 1024;
            const s16x4 a0 = vtr(vp), a1 = vtr(vp + 512), b0 = vtr(vp + 4096), b1 = vtr(vp + 4096 + 512);
            const bf16x8 v0 = __builtin_shufflevector(a0, a1, 0, 1, 2, 3, 4, 5, 6, 7), v1 = __builtin_shufflevector(b0, b1, 0, 1, 2, 3, 4, 5, 6, 7);
            o0 = MFMA32(v0, pf[kk], o0); o1 = MFMA32(v1, pf[kk], o1);
        }
        if (it + 1 < nt) LSTORE((it + 1) & 1);
        const int alldone = __all(carry < 0x1p-120f) ? 1 : 0;
        if (lane == 0) sflag[(it & 1) * 4 + wid] = alldone;
        __syncthreads();
        if ((sflag[(it & 1) * 4] & sflag[(it & 1) * 4 + 1] & sflag[(it & 1) * 4 + 2] & sflag[(it & 1) * 4 + 3]) != 0) break;
    }
#undef GLOAD
#undef LSTORE
    float ss = 0.f;
#pragma unroll
    for (int e = 0; e < 16; ++e) ss += o0[e] * o0[e] + o1[e] * o1[e];
    float slo, shi; swap32(ss, slo, shi);
    const float rinv = rsqrtf((slo + shi) * (1.f / 64) + EPS);
    bfu* yp = y + act_off((size_t)b * S_ + qg, hh * 64) + 4 * h;
    const float* gp = og + hh * 64 + 4 * h;
#pragma unroll
    for (int g = 0; g < 4; ++g) {
        const float4 g0 = *(const float4*)(gp + 8 * g), g1 = *(const float4*)(gp + 32 + 8 * g);
        *(uint2*)(yp + 8 * g) = make_uint2(pk2(o0[4 * g] * rinv * g0.x, o0[4 * g + 1] * rinv * g0.y), pk2(o0[4 * g + 2] * rinv * g0.z, o0[4 * g + 3] * rinv * g0.w));
        *(uint2*)(yp + (size_t)T_ * 32 + 8 * g) = make_uint2(pk2(o1[4 * g] * rinv * g1.x, o1[4 * g + 1] * rinv * g1.y), pk2(o1[4 * g + 2] * rinv * g1.z, o1[4 * g + 3] * rinv * g1.w));
    }
}

__device__ __forceinline__ void d_cvt_sgw(const int vb, const float* __restrict__ src, bfu* __restrict__ dst) {
    const size_t e = (size_t)vb * 2048 + otid() * 8;
    const int s0 = (int)(e & 127), t = (int)((e >> 7) & 127);
    const float4 a = *(const float4*)(src + e), b = *(const float4*)(src + e + 4);
    const float v[8] = {a.x, a.y, a.z, a.w, b.x, b.y, b.z, b.w};
    u32x4 o;
#pragma unroll
    for (int i = 0; i < 4; ++i) o[i] = pk2(s0 + 2 * i <= t ? v[2 * i] : 0.f, s0 + 2 * i + 1 <= t ? v[2 * i + 1] : 0.f);
    *(u32x4*)(dst + e) = o;
}

__device__ __forceinline__ float silu_f(float x) { return x * __builtin_amdgcn_rcpf(1.f + __expf(-x)); }
__device__ __forceinline__ void ml_scan(const float* __restrict__ gi, const float* __restrict__ glf, const int lane, float* s_b, float* s_a, float* s_A, float& b_last, float& A_last) {
    const float2 f = *(const float2*)(glf + 2 * lane), iv = *(const float2*)(gi + 2 * lane);
    float x = f.x + f.y;
#pragma unroll
    for (int o = 1; o < 64; o <<= 1) { const float t = __shfl_up(x, o, 64); if (lane >= o) x += t; }
    const float b1 = x, b0 = x - f.y;
    const float a0 = iv.x - b0, a1 = iv.y - b1;
    float m = fmaxf(a0, a1);
#pragma unroll
    for (int o = 1; o < 64; o <<= 1) { const float t = __shfl_up(m, o, 64); if (lane >= o) m = fmaxf(m, t); }
    float prev = __shfl_up(m, 1, 64); if (lane == 0) prev = -INFINITY;
    *(float2*)(s_b + 2 * lane) = make_float2(b0, b1);
    *(float2*)(s_a + 2 * lane) = make_float2(a0, a1);
    *(float2*)(s_A + 2 * lane) = make_float2(fmaxf(prev, a0), m);
    b_last = __shfl(b1, 63, 64); A_last = __shfl(m, 63, 64);
}
__device__ __forceinline__ void conv8(const bfu* __restrict__ raw, const int sg, const int ch, const float* __restrict__ cw, const float* __restrict__ cb, float (&out)[8]) {
    const float4 b0 = *(const float4*)(cb + ch * 8), b1 = *(const float4*)(cb + ch * 8 + 4);
    out[0] = b0.x; out[1] = b0.y; out[2] = b0.z; out[3] = b0.w; out[4] = b1.x; out[5] = b1.y; out[6] = b1.z; out[7] = b1.w;
#pragma unroll
    for (int j = 0; j < 4; ++j) {
        const int sp = sg - 3 + j;
        u32x4 v = {0u, 0u, 0u, 0u};
        if (sp >= 0) v = *(const u32x4*)(raw + ((size_t)ch * S_ + sp) * 8);
        const float4 w0 = *(const float4*)(cw + j * 768 + ch * 8), w1 = *(const float4*)(cw + j * 768 + ch * 8 + 4);
        out[0] += bflo(v[0]) * w0.x; out[1] += bfhi(v[0]) * w0.y; out[2] += bflo(v[1]) * w0.z; out[3] += bfhi(v[1]) * w0.w;
        out[4] += bflo(v[2]) * w1.x; out[5] += bfhi(v[2]) * w1.y; out[6] += bflo(v[3]) * w1.z; out[7] += bfhi(v[3]) * w1.w;
    }
#pragma unroll
    for (int i = 0; i < 8; ++i) out[i] = silu_f(out[i]);
}
__device__ __forceinline__ u32x4 pack8(const float (&v)[8], const float sc) {
    u32x4 o; o[0] = pk2(v[0] * sc, v[1] * sc); o[1] = pk2(v[2] * sc, v[3] * sc); o[2] = pk2(v[4] * sc, v[5] * sc); o[3] = pk2(v[6] * sc, v[7] * sc); return o;
}
__device__ __forceinline__ bf16x8 trfrag(const char* p, const int second) {
    const s16x4 a = vtr(p), b = vtr(p + second);
    return __builtin_shufflevector(a, b, 0, 1, 2, 3, 4, 5, 6, 7);
}
constexpr int MLA_LDS = 2048 + 32768 + 1024;
__device__ __forceinline__ void d_ml_a(const int unit, const bfu* __restrict__ mkr, const bfu* __restrict__ mvr, const float* __restrict__ gi, const float* __restrict__ glf,
                                       const float* __restrict__ cw, const float* __restrict__ cb, float* __restrict__ Wloc, float* __restrict__ nloc, float* __restrict__ scal, char* lds) {
    const int bh = unit >> 5, c = unit & 31, hh = bh % 6;
    const int tid = otid(), lane = tid & 63, r = lane & 31, h = lane >> 5;
    const int wid = __builtin_amdgcn_readfirstlane(tid >> 6);
    float* s_ws = (float*)lds; float* s_a = s_ws + 128; float* s_b = s_a + 128; float* s_A = s_b + 128;
    char* KW = lds + 2048; char* VI = KW + 16384; float* s_ns = (float*)(VI + 16384);
    __syncthreads();
    if (wid == 0) {
        float bl, al;
        ml_scan(gi + (size_t)bh * S_ + c * 128, glf + (size_t)bh * S_ + c * 128, lane, s_b, s_a, s_A, bl, al);
        const float2 a2 = *(const float2*)(s_a + 2 * lane);
        *(float2*)(s_ws + 2 * lane) = make_float2(__expf(a2.x - al), __expf(a2.y - al));
        if (lane == 0) { scal[(size_t)unit * 2] = bl; scal[(size_t)unit * 2 + 1] = al; }
    }
    __syncthreads();
    const bfu* kraw = mkr + (size_t)bh * S_ * 64; const bfu* vraw = mvr + (size_t)bh * S_ * 64;
#pragma unroll 1
    for (int it = 0; it < 4; ++it) {
        const int item = tid + 256 * it, s = item >> 3, ch = item & 7;
        float kv[8]; conv8(kraw, c * 128 + s, ch, cw + 384 + hh * 64, cb + 384 + hh * 64, kv);
        const int off = (ch >> 2) * 8192 + s * 64 + (ch & 3) * 16;
        *(u32x4*)(KW + off) = pack8(kv, 0.125f * s_ws[s]);
        *(u32x4*)(VI + off) = *(const u32x4*)(vraw + ((size_t)ch * S_ + c * 128 + s) * 8);
    }
    __syncthreads();
    {
        const int dvt = wid >> 1, dkt = wid & 1;
        const int trn = ((lane >> 4) & 1) * 32 + (lane & 3) * 8 + (8 * h + ((lane & 15) >> 2)) * 64;
        f32x16 acc;
#pragma unroll
        for (int e = 0; e < 16; ++e) acc[e] = 0.f;
#pragma unroll
        for (int ks = 0; ks < 8; ++ks) {
            const bf16x8 af = trfrag(VI + dvt * 8192 + trn + ks * 1024, 256), bf = trfrag(KW + dkt * 8192 + trn + ks * 1024, 256);
            acc = MFMA32(af, bf, acc);
        }
        float* wp = Wloc + (size_t)unit * 4096 + (size_t)(32 * dvt) * 64 + 32 * dkt + r;
#pragma unroll
        for (int e = 0; e < 16; ++e) wp[crow(e, h) * 64] = acc[e];
        const int dk = tid & 63, part = tid >> 6;
        float ns = 0.f;
        const char* kp = KW + (dk >> 5) * 8192 + (dk & 31) * 2 + part * 32 * 64;
#pragma unroll 8
        for (int s = 0; s < 32; ++s) ns += bf2f(*(const bfu*)(kp + s * 64));
        s_ns[part * 64 + dk] = ns;
    }
    __syncthreads();
    if (tid < 64) nloc[(size_t)unit * 64 + tid] = (s_ns[tid] + s_ns[64 + tid]) + (s_ns[128 + tid] + s_ns[192 + tid]);
}
constexpr int MLB_LDS = 2304 + 3 * 16384 + 8192;
__device__ __forceinline__ void d_ml_b(const int unit, const bfu* __restrict__ mqr, const bfu* __restrict__ mkr, const bfu* __restrict__ mvr, const bfu* __restrict__ mo,
                                       const float* __restrict__ gi, const float* __restrict__ glf, const float* __restrict__ cw, const float* __restrict__ cb,
                                       const float* __restrict__ Wloc, const float* __restrict__ nloc, const float* __restrict__ scal,
                                       const float* __restrict__ og, bfu* __restrict__ y, char* lds) {
    const int c = 31 - unit / 48, bh = unit % 48, b = bh / 6, hh = bh % 6;
    const int tid = otid(), lane = tid & 63, r = lane & 31, h = lane >> 5;
    const int wid = __builtin_amdgcn_readfirstlane(tid >> 6);
    float* s_b = (float*)lds; float* s_a = s_b + 128; float* s_A = s_a + 128; float* s_n = s_A + 128; float* s_coef = s_n + 64;
    float* s_dlog = s_coef + 32; float* s_alog = s_dlog + 32; float* s_mp = s_alog + 32;
    char* QI = lds + 2304; char* KI = QI + 16384; char* VI = KI + 16384; char* CI = VI + 16384;
    __syncthreads();
    if (wid == 0) { float bl, al; ml_scan(gi + (size_t)bh * S_ + c * 128, glf + (size_t)bh * S_ + c * 128, lane, s_b, s_a, s_A, bl, al); }
    else if (wid == 1) {
        float blv = 0.f, alv = 0.f;
        if (lane < c) { blv = scal[((size_t)bh * 32 + lane) * 2]; alv = scal[((size_t)bh * 32 + lane) * 2 + 1]; }
        float m = 0.f, mydl = 0.f, myal = 0.f;
        for (int j = 0; j < c; ++j) {
            const float bl = __shfl(blv, j, 64), al = __shfl(alv, j, 64);
            const float M = fmaxf(m, al);
            if (lane == j) { mydl = m - M; myal = al - M; }
            m = bl + M;
        }
        if (lane < 32) { s_dlog[lane] = mydl; s_alog[lane] = myal; }
        if (lane == 0) s_mp[0] = m;
    }
    {
        const bfu* qraw = mqr + (size_t)bh * S_ * 64; const bfu* kraw = mkr + (size_t)bh * S_ * 64; const bfu* vraw = mvr + (size_t)bh * S_ * 64;
#pragma unroll 1
        for (int it = 0; it < 4; ++it) {
            const int item = tid + 256 * it, s = item >> 3, ch = item & 7;
            float v8[8];
            conv8(qraw, c * 128 + s, ch, cw + hh * 64, cb + hh * 64, v8);
            const int ro = s * 128 + ((ch ^ (s & 7)) << 4);
            *(u32x4*)(QI + ro) = pack8(v8, 1.f);
            conv8(kraw, c * 128 + s, ch, cw + 384 + hh * 64, cb + 384 + hh * 64, v8);
            *(u32x4*)(KI + ro) = pack8(v8, 0.125f);
            *(u32x4*)(VI + (ch >> 2) * 8192 + s * 64 + (ch & 3) * 16) = *(const u32x4*)(vraw + ((size_t)ch * S_ + c * 128 + s) * 8);
        }
    }
    __syncthreads();
    if (tid < 32) {
        float L = s_alog[tid];
        for (int j = tid + 1; j < c; ++j) L += s_dlog[j];
        s_coef[tid] = (tid < c) ? __expf(L) : 0.f;
    }
    __syncthreads();
    {
        float4 acc[4];
#pragma unroll
        for (int i = 0; i < 4; ++i) acc[i] = make_float4(0.f, 0.f, 0.f, 0.f);
        float nacc = 0.f;
        const float* wb = Wloc + (size_t)bh * 32 * 4096 + tid * 4;
#pragma unroll 2
        for (int j = 0; j < c; ++j) {
            const float cf = s_coef[j];
#pragma unroll
            for (int i = 0; i < 4; ++i) { const float4 w = *(const float4*)(wb + (size_t)j * 4096 + 1024 * i); acc[i].x += cf * w.x; acc[i].y += cf * w.y; acc[i].z += cf * w.z; acc[i].w += cf * w.w; }
            if (tid < 64) nacc += cf * nloc[((size_t)bh * 32 + j) * 64 + tid];
        }
#pragma unroll
        for (int i = 0; i < 4; ++i) {
            const int e = tid * 4 + 1024 * i, dv = e >> 6, dk = e & 63;
            *(uint2*)(CI + dv * 128 + (((dk >> 3) ^ (dv & 7)) << 4) + (dk & 7) * 2) = make_uint2(pk2(acc[i].x, acc[i].y), pk2(acc[i].z, acc[i].w));
        }
        if (tid < 64) s_n[tid] = nacc;
    }
    __syncthreads();
    {
        const int t = 32 * wid + r, tg = c * 128 + t, sw = r & 7;
        const float m_prev = s_mp[0];
        bf16x8 qf[4];
#pragma unroll
        for (int ks = 0; ks < 4; ++ks) qf[ks] = *(const bf16x8*)(QI + t * 128 + (((2 * ks + h) ^ sw) << 4));
        const float Mt = fmaxf(m_prev, s_A[t]);
        const float isc = __expf(m_prev - Mt);
        f32x16 n0, n1;
#pragma unroll
        for (int e = 0; e < 16; ++e) { n0[e] = 0.f; n1[e] = 0.f; }
        float dsum = 0.f;
        const int trp = ((lane >> 4) & 1) * 32 + (lane & 3) * 8 + (4 * h + ((lane & 15) >> 2)) * 64;
#pragma unroll 1
        for (int u = 0; u <= wid; ++u) {
            f32x16 pacc;
#pragma unroll
            for (int e = 0; e < 16; ++e) pacc[e] = 0.f;
#pragma unroll
            for (int ks = 0; ks < 4; ++ks) {
                const bf16x8 kf = *(const bf16x8*)(KI + (32 * u + r) * 128 + (((2 * ks + h) ^ sw) << 4));
                pacc = MFMA32(kf, qf[ks], pacc);
            }
            float pw[16];
#pragma unroll
            for (int g = 0; g < 4; ++g) {
                const float4 a4 = *(const float4*)(s_a + 32 * u + 8 * g + 4 * h);
                const float av[4] = {a4.x, a4.y, a4.z, a4.w};
#pragma unroll
                for (int i = 0; i < 4; ++i) {
                    float val = pacc[4 * g + i] * __expf(av[i] - Mt);
                    if (u == wid && (8 * g + 4 * h + i) > r) val = 0.f;
                    dsum += val; pw[4 * g + i] = val;
                }
            }
            u32x4 pa, pb;
#pragma unroll
            for (int i = 0; i < 4; ++i) { pa[i] = pk2(pw[2 * i], pw[2 * i + 1]); pb[i] = pk2(pw[8 + 2 * i], pw[8 + 2 * i + 1]); }
            const bf16x8 pf0 = __builtin_bit_cast(bf16x8, pa), pf1 = __builtin_bit_cast(bf16x8, pb);
            const char* vp = VI + trp + (2 * u) * 1024;
            n0 = MFMA32(trfrag(vp, 512), pf0, n0); n1 = MFMA32(trfrag(vp + 8192, 512), pf0, n1);
            n0 = MFMA32(trfrag(vp + 1024, 512), pf1, n0); n1 = MFMA32(trfrag(vp + 8192 + 1024, 512), pf1, n1);
        }
        f32x16 i0, i1;
#pragma unroll
        for (int e = 0; e < 16; ++e) { i0[e] = 0.f; i1[e] = 0.f; }
        float qn = 0.f;
#pragma unroll
        for (int ks = 0; ks < 4; ++ks) {
            const int co = ((2 * ks + h) ^ sw) << 4;
            const bf16x8 c0 = *(const bf16x8*)(CI + r * 128 + co), c1 = *(const bf16x8*)(CI + (32 + r) * 128 + co);
            i0 = MFMA32(c0, qf[ks], i0); i1 = MFMA32(c1, qf[ks], i1);
            const u32x4 qu = __builtin_bit_cast(u32x4, qf[ks]);
            const float4 na = *(const float4*)(s_n + 16 * ks + 8 * h), nb = *(const float4*)(s_n + 16 * ks + 8 * h + 4);
            qn += bflo(qu[0]) * na.x + bfhi(qu[0]) * na.y + bflo(qu[1]) * na.z + bfhi(qu[1]) * na.w + bflo(qu[2]) * nb.x + bfhi(qu[2]) * nb.y + bflo(qu[3]) * nb.z + bfhi(qu[3]) * nb.w;
        }
        float lo, hi2; swap32(dsum, lo, hi2); const float dtot = lo + hi2;
        swap32(qn, lo, hi2); const float qtot = lo + hi2;
        const float den = dtot + isc * qtot;
        const float mt = s_b[t] + Mt;
        const float inv = 1.f / fmaxf(fabsf(den), __expf(-mt));
        float ss = 0.f;
#pragma unroll
        for (int e = 0; e < 16; ++e) { n0[e] = (n0[e] + isc * i0[e]) * inv; n1[e] = (n1[e] + isc * i1[e]) * inv; ss += n0[e] * n0[e] + n1[e] * n1[e]; }
        swap32(ss, lo, hi2);
        const float rinv = rsqrtf((lo + hi2) * (1.f / 64) + EPS);
        const size_t trow = (size_t)b * S_ + tg;
        bfu* yp = y + act_off(trow, 384 + hh * 64) + 4 * h;
        const bfu* op = mo + ((size_t)hh * 8 * T_ + trow) * 8 + 4 * h;
        const float* gp = og + (6 + hh) * 64 + 4 * h;
#pragma unroll
        for (int g = 0; g < 4; ++g) {
            const float4 g0 = *(const float4*)(gp + 8 * g), g1 = *(const float4*)(gp + 32 + 8 * g);
            const uint2 o0 = *(const uint2*)(op + (size_t)g * T_ * 8), o1 = *(const uint2*)(op + (size_t)(4 + g) * T_ * 8);
            *(uint2*)(yp + 8 * g) = make_uint2(pk2(n0[4 * g] * rinv * g0.x * bflo(o0.x), n0[4 * g + 1] * rinv * g0.y * bfhi(o0.x)), pk2(n0[4 * g + 2] * rinv * g0.z * bflo(o0.y), n0[4 * g + 3] * rinv * g0.w * bfhi(o0.y)));
            *(uint2*)(yp + (size_t)T_ * 32 + 8 * g) = make_uint2(pk2(n1[4 * g] * rinv * g1.x * bflo(o1.x), n1[4 * g + 1] * rinv * g1.y * bfhi(o1.x)), pk2(n1[4 * g + 2] * rinv * g1.z * bflo(o1.y), n1[4 * g + 3] * rinv * g1.w * bfhi(o1.y)));
        }
    }
}
constexpr int SG_LDS = 16384;
__device__ __forceinline__ void d_sg2(const int unit, const bfu* __restrict__ su, const bfu* __restrict__ svh, const bfu* __restrict__ wm, const float* __restrict__ bs,
                                      const float* __restrict__ og, bfu* __restrict__ y, char* lds) {
    const int g = unit & 3, c = (unit >> 2) & 31, b = unit >> 7;
    const int tid = otid(), lane = tid & 63, r = lane & 31, h = lane >> 5;
    const int wid = __builtin_amdgcn_readfirstlane(tid >> 6);
    char* VI = lds;
    __syncthreads();
    const bfu* vraw = svh + ((size_t)b * 4 + g) * S_ * 64 + (size_t)c * 128 * 8;
#pragma unroll
    for (int it = 0; it < 4; ++it) {
        const int item = tid + 256 * it, s = item >> 3, ch = item & 7;
        *(u32x4*)(VI + (ch >> 2) * 8192 + s * 64 + (ch & 3) * 16) = *(const u32x4*)(vraw + ((size_t)ch * S_ + s) * 8);
    }
    __syncthreads();
    const int t = 32 * wid + r;
    const int trn = ((lane >> 4) & 1) * 32 + (lane & 3) * 8 + (8 * h + ((lane & 15) >> 2)) * 64;
    f32x16 a0, a1;
#pragma unroll
    for (int e = 0; e < 16; ++e) { a0[e] = 0.f; a1[e] = 0.f; }
    const bfu* wr = wm + ((size_t)g * 128 + t) * 128 + 8 * h;
#pragma unroll 1
    for (int ks = 0; ks < 2 * wid + 2; ++ks) {
        const bf16x8 wf = *(const bf16x8*)(wr + 16 * ks);
        a0 = MFMA32(trfrag(VI + trn + ks * 1024, 256), wf, a0);
        a1 = MFMA32(trfrag(VI + 8192 + trn + ks * 1024, 256), wf, a1);
    }
    const float bias = bs[g * 128 + t];
    const size_t trow = (size_t)b * S_ + c * 128 + t;
    const bfu* up = su + ((size_t)g * 8 * T_ + trow) * 8 + 4 * h;
    float ss = 0.f;
#pragma unroll
    for (int q = 0; q < 4; ++q) {
        const uint2 u0 = *(const uint2*)(up + (size_t)q * T_ * 8), u1 = *(const uint2*)(up + (size_t)(4 + q) * T_ * 8);
        a0[4 * q] = (a0[4 * q] + bias) * bflo(u0.x); a0[4 * q + 1] = (a0[4 * q + 1] + bias) * bfhi(u0.x); a0[4 * q + 2] = (a0[4 * q + 2] + bias) * bflo(u0.y); a0[4 * q + 3] = (a0[4 * q + 3] + bias) * bfhi(u0.y);
        a1[4 * q] = (a1[4 * q] + bias) * bflo(u1.x); a1[4 * q + 1] = (a1[4 * q + 1] + bias) * bfhi(u1.x); a1[4 * q + 2] = (a1[4 * q + 2] + bias) * bflo(u1.y); a1[4 * q + 3] = (a1[4 * q + 3] + bias) * bfhi(u1.y);
    }
#pragma unroll
    for (int e = 0; e < 16; ++e) ss += a0[e] * a0[e] + a1[e] * a1[e];
    float lo, hi2; swap32(ss, lo, hi2);
    const float rinv = rsqrtf((lo + hi2) * (1.f / 64) + EPS);
    bfu* yp = y + act_off(trow, 768 + g * 64) + 4 * h;
    const float* gp = og + (12 + g) * 64 + 4 * h;
#pragma unroll
    for (int q = 0; q < 4; ++q) {
        const float4 g0 = *(const float4*)(gp + 8 * q), g1 = *(const float4*)(gp + 32 + 8 * q);
        *(uint2*)(yp + 8 * q) = make_uint2(pk2(a0[4 * q] * rinv * g0.x, a0[4 * q + 1] * rinv * g0.y), pk2(a0[4 * q + 2] * rinv * g0.z, a0[4 * q + 3] * rinv * g0.w));
        *(uint2*)(yp + (size_t)T_ * 32 + 8 * q) = make_uint2(pk2(a1[4 * q] * rinv * g1.x, a1[4 * q + 1] * rinv * g1.y), pk2(a1[4 * q + 2] * rinv * g1.z, a1[4 * q + 3] * rinv * g1.w));
    }
}

#define CE_D(a, b) { const float hi_ = fmaxf(a, b), lo_ = fminf(a, b); a = hi_; b = lo_; }
template <int B>
__device__ __forceinline__ void sort16_desc(float (&v)[64]) {
#define C2_(a, b) CE_D(v[B + a], v[B + b])
    C2_(0, 13) C2_(1, 12) C2_(2, 15) C2_(3, 14) C2_(4, 8) C2_(5, 6) C2_(7, 11) C2_(9, 10)
    C2_(0, 5) C2_(1, 7) C2_(2, 9) C2_(3, 4) C2_(6, 13) C2_(8, 14) C2_(10, 15) C2_(11, 12)
    C2_(0, 1) C2_(2, 3) C2_(4, 5) C2_(6, 8) C2_(7, 9) C2_(10, 11) C2_(12, 13) C2_(14, 15)
    C2_(0, 2) C2_(1, 3) C2_(4, 10) C2_(5, 11) C2_(6, 7) C2_(8, 9) C2_(12, 14) C2_(13, 15)
    C2_(1, 2) C2_(3, 12) C2_(4, 6) C2_(5, 7) C2_(8, 10) C2_(9, 11) C2_(13, 14)
    C2_(1, 4) C2_(2, 6) C2_(5, 8) C2_(7, 10) C2_(9, 13) C2_(11, 14)
    C2_(2, 4) C2_(3, 6) C2_(9, 12) C2_(11, 13)
    C2_(3, 5) C2_(6, 8) C2_(7, 9) C2_(10, 12)
    C2_(3, 4) C2_(5, 6) C2_(7, 8) C2_(9, 10) C2_(11, 12)
    C2_(6, 7) C2_(8, 9)
#undef C2_
}
template <int A0, int B0>
__device__ __forceinline__ void merge_top16(float (&v)[64]) {
#pragma unroll
    for (int i = 0; i < 16; ++i) v[A0 + i] = fmaxf(v[A0 + i], v[B0 + 15 - i]);
#pragma unroll
    for (int j = 8; j > 0; j >>= 1)
#pragma unroll
        for (int i = 0; i < 16; ++i) { const int l = i ^ j; if (l > i) { CE_D(v[A0 + i], v[A0 + l]); } }
}
__device__ __forceinline__ void top16_of_64(float (&v)[64]) {
    sort16_desc<0>(v); sort16_desc<16>(v); sort16_desc<32>(v); sort16_desc<48>(v);
    merge_top16<0, 16>(v); merge_top16<32, 48>(v); merge_top16<0, 32>(v);
}
__device__ __forceinline__ void d_compose_wq(const int unit, const float* __restrict__ wq_all, const float* __restrict__ keys_all, bfu* __restrict__ wt_all) {
    const int l = unit >> 7, hc = (unit >> 3) & 15, kb = unit & 7;
    const int tid = otid(), lane = tid & 63, r = lane & 31, h = lane >> 5;
    const int w = __builtin_amdgcn_readfirstlane(tid >> 6);
    const float* wq = wq_all + (size_t)l * D_ * 2048 + (size_t)(kb * 128 + w * 32 + r) * 2048 + hc * 128 + 8 * h;
    const float* ky = keys_all + ((size_t)l * 16 + hc) * 128 * 128 + (size_t)r * 128 + 8 * h;
    bf16x8 af[8];
#pragma unroll
    for (int ks = 0; ks < 8; ++ks) {
        const float4 a = *(const float4*)(wq + 16 * ks), b = *(const float4*)(wq + 16 * ks + 4);
        u32x4 o; o[0] = pk2(a.x, a.y); o[1] = pk2(a.z, a.w); o[2] = pk2(b.x, b.y); o[3] = pk2(b.z, b.w);
        af[ks] = __builtin_bit_cast(bf16x8, o);
    }
    unsigned char* dst = (unsigned char*)wt_all + (size_t)l * 2048 * D_ + ((size_t)(kb * 2 + (w >> 1)) * 2048 + hc * 128 + r) * 64 + (w & 1) * 32 + 4 * h;
#pragma unroll 1
    for (int nt = 0; nt < 4; ++nt) {
        f32x16 acc;
#pragma unroll
        for (int e = 0; e < 16; ++e) acc[e] = 0.f;
#pragma unroll
        for (int ks = 0; ks < 8; ++ks) {
            const float4 a = *(const float4*)(ky + (size_t)nt * 32 * 128 + 16 * ks), b = *(const float4*)(ky + (size_t)nt * 32 * 128 + 16 * ks + 4);
            u32x4 o; o[0] = pk2(a.x, a.y); o[1] = pk2(a.z, a.w); o[2] = pk2(b.x, b.y); o[3] = pk2(b.z, b.w);
            acc = MFMA32(af[ks], __builtin_bit_cast(bf16x8, o), acc);
        }
#pragma unroll
        for (int g = 0; g < 4; ++g) {
            int w8 = __builtin_amdgcn_cvt_pk_fp8_f32(acc[4 * g] * 64.f, acc[4 * g + 1] * 64.f, 0, false);
            w8 = __builtin_amdgcn_cvt_pk_fp8_f32(acc[4 * g + 2] * 64.f, acc[4 * g + 3] * 64.f, w8, true);
            *(int*)(dst + (size_t)nt * 32 * 64 + 8 * g) = w8;
        }
    }
}
struct EpiScore {
    float* TOPK;
    __device__ __forceinline__ void operator()(f32x16 (&acc)[2][4], int abase, int bbase, int r, int h, char* xl, int wa, int wb) const {
        const int hc = abase >> 7;
        const unsigned nb = (unsigned)(wa * 64 + 4 * h);
        float keep[2][16];
#pragma unroll
        for (int pass = 0; pass < 2; ++pass)
#pragma unroll
            for (int jj = 0; jj < 2; ++jj) {
                float v[64];
#pragma unroll
                for (int i = 0; i < 2; ++i)
#pragma unroll
                    for (int e = 0; e < 16; ++e) {
                        const float lo = acc[i][jj][e], hi = acc[i][2 + jj][e];
                        const float x = (pass == 0) ? (wa ? lo : hi) : (wa ? hi : lo);
                        v[16 * i + e] = __uint_as_float((__float_as_uint(x) & 0xFFFFFF80u) | (nb + (unsigned)(32 * i + (e & 3) + 8 * (e >> 2))));
                    }
                sort16_desc<0>(v); sort16_desc<16>(v); merge_top16<0, 16>(v);
#pragma unroll
                for (int i = 0; i < 16; ++i) { float lo, hi2; swap32(v[i], lo, hi2); v[16 + i] = h ? lo : hi2; }
                merge_top16<0, 16>(v);
                if (pass == 0) {
                    if (h == 0) {
                        float4* sp = (float4*)(xl + ((((wb * 2 + wa) * 2 + jj) * 32 + r) << 6));
#pragma unroll
                        for (int q = 0; q < 4; ++q) sp[q] = make_float4(v[4 * q], v[4 * q + 1], v[4 * q + 2], v[4 * q + 3]);
                    }
                } else {
#pragma unroll
                    for (int i = 0; i < 16; ++i) keep[jj][i] = v[i];
                }
            }
        __syncthreads();
#pragma unroll
        for (int jj = 0; jj < 2; ++jj) {
            float v[64];
            const float4* sp = (const float4*)(xl + ((((wb * 2 + (wa ^ 1)) * 2 + jj) * 32 + r) << 6));
#pragma unroll
            for (int q = 0; q < 4; ++q) { const float4 t4 = sp[q]; v[16 + 4 * q] = t4.x; v[16 + 4 * q + 1] = t4.y; v[16 + 4 * q + 2] = t4.z; v[16 + 4 * q + 3] = t4.w; }
#pragma unroll
            for (int i = 0; i < 16; ++i) v[i] = keep[jj][i];
            merge_top16<0, 16>(v);
            const int token = bbase + 32 * (wa ? 2 + jj : jj) + r;
            float4* dp = (float4*)(TOPK + ((size_t)token * 16 + hc) * 16 + 8 * h);
            if (h == 0) { dp[0] = make_float4(v[0], v[1], v[2], v[3]); dp[1] = make_float4(v[4], v[5], v[6], v[7]); }
            else { dp[0] = make_float4(v[8], v[9], v[10], v[11]); dp[1] = make_float4(v[12], v[13], v[14], v[15]); }
        }
        __syncthreads();
    }
};
__device__ __forceinline__ void d_peer_cand(const int vb, const float* __restrict__ topk, int* __restrict__ idx, float* __restrict__ gate) {
    const size_t pidx = (size_t)vb * 256 + otid();
    const float4* tp = (const float4*)(topk + pidx * 32);
    float top[2][16];
#pragma unroll
    for (int c = 0; c < 2; ++c)
#pragma unroll
        for (int q = 0; q < 4; ++q) { const float4 t4 = tp[4 * c + q]; top[c][4 * q] = t4.x; top[c][4 * q + 1] = t4.y; top[c][4 * q + 2] = t4.z; top[c][4 * q + 3] = t4.w; }
    float cd[64];
    {
        unsigned i1[16], i2[16];
#pragma unroll
        for (int i = 0; i < 16; ++i) { i1[i] = (__float_as_uint(top[0][i]) & 127u) << 7; i2[i] = __float_as_uint(top[1][i]) & 127u; }
#define CAND_(i, j) __uint_as_float((__float_as_uint(top[0][i] + top[1][j]) & 0xFFFFC000u) | i1[i] | i2[j])
#pragma unroll
        for (int q = 0; q < 16; ++q) { cd[q] = CAND_(0, q); cd[32 + q] = (q < 15) ? CAND_((q < 15 ? q + 1 : 15), 0) : -INFINITY; }
        int n = 0;
#pragma unroll
        for (int i = 1; i < 8; ++i)
#pragma unroll
            for (int jj = 1; jj < 8; ++jj)
                if ((i + 1) * (jj + 1) <= 16) { if (n < 16) cd[16 + n] = CAND_(i, jj); else cd[48 + n - 16] = CAND_(i, jj); ++n; }
#undef CAND_
#pragma unroll
        for (int q = 3; q < 16; ++q) cd[48 + q] = -INFINITY;
    }
    sort16_desc<16>(cd); merge_top16<0, 16>(cd);
    sort16_desc<48>(cd); merge_top16<32, 48>(cd);
#pragma unroll
    for (int i = 0; i < 16; ++i) cd[i] = fmaxf(cd[i], cd[47 - i]);
    float gsum = 0.f; float gv[16]; int ids[16];
    const float vmax = __uint_as_float(__float_as_uint(top[0][0] + top[1][0]) & 0xFFFFC000u);
#pragma unroll
    for (int i = 0; i < 16; ++i) {
        const unsigned b = __float_as_uint(cd[i]);
        ids[i] = (int)(b & 0x3FFFu);
        gv[i] = __expf((__uint_as_float(b & 0xFFFFC000u) - vmax) * (1.f / 64.f)); gsum += gv[i];
    }
    const float ginv = 1.f / gsum;
    int4* ip = (int4*)(idx + pidx * 16); float4* gp = (float4*)(gate + pidx * 16);
#pragma unroll
    for (int i = 0; i < 4; ++i) {
        ip[i] = make_int4(ids[4 * i], ids[4 * i + 1], ids[4 * i + 2], ids[4 * i + 3]);
        gp[i] = make_float4(gv[4 * i] * ginv, gv[4 * i + 1] * ginv, gv[4 * i + 2] * ginv, gv[4 * i + 3] * ginv);
    }
}
constexpr int ROUTE_LDS = 65536;
__device__ __forceinline__ void d_peer_route3(const int bid, const int G, const bfu* __restrict__ pq, const bfu* __restrict__ keys, int* __restrict__ idx, float* __restrict__ gate, char* lds) {
    const int hd = bid & 7, tb0 = bid >> 3, tstep = G >> 3, NTB = T_ / 128;
    if (tb0 >= NTB) return;
    const int tid = otid();
    const int wid = __builtin_amdgcn_readfirstlane(tid >> 6);
    bf16x8 qf0[8];
    {
        const int lane = tid & 63;
        const bfu* qrow = pq + ((size_t)(hd * 32 + (lane >> 5)) * T_ + tb0 * 128 + wid * 32 + (lane & 31)) * 8;
#pragma unroll
        for (int ks = 0; ks < 8; ++ks) qf0[ks] = *(const bf16x8*)(qrow + (size_t)(2 * ks) * T_ * 8);
    }
    __syncthreads();
    {
        const bfu* kg = keys + (size_t)hd * 2 * 128 * 128;
#pragma unroll
        for (int it = 0; it < 16; ++it) {
            const int cidx = tid + 256 * it, n = cidx >> 4, ch = cidx & 15;
            *(u32x4*)(lds + n * 256 + ((ch ^ (n & 15)) << 4)) = *(const u32x4*)(kg + (size_t)cidx * 8);
        }
    }
    __syncthreads();
#pragma unroll 1
    for (int tb = tb0; tb < NTB; tb += tstep) {
        const int lane = otid() & 63, r = lane & 31, h = lane >> 5;
        const bfu* qbase = pq + ((size_t)(hd * 32 + h) * T_ + wid * 32 + r) * 8;
        const int t = tb * 128 + wid * 32 + r;
        const int tbn = (tb + tstep < NTB) ? tb + tstep : tb;
        float top[2][16];
        bf16x8 qf1[8];
        {
            const bfu* qrow = qbase + (size_t)tb * 128 * 8;
#pragma unroll
            for (int ks = 0; ks < 8; ++ks) qf1[ks] = *(const bf16x8*)(qrow + (size_t)(16 + 2 * ks) * T_ * 8);
        }
#pragma unroll
        for (int c = 0; c < 2; ++c) {
            float v[64];
#pragma unroll
            for (int mt = 0; mt < 4; ++mt) {
                f32x16 acc;
#pragma unroll
                for (int e = 0; e < 16; ++e) acc[e] = 0.f;
                const char* kb = lds + c * 32768 + (32 * mt + r) * 256;
#pragma unroll
                for (int ks = 0; ks < 8; ++ks) acc = MFMA32(*(const bf16x8*)(kb + (((2 * ks + h) ^ (r & 15)) << 4)), c ? qf1[ks] : qf0[ks], acc);
#pragma unroll
                for (int e = 0; e < 16; ++e) {
                    const unsigned n = (unsigned)(32 * mt + (e & 3) + 8 * (e >> 2)) | (unsigned)(4 * h);
                    v[16 * mt + e] = __uint_as_float((__float_as_uint(acc[e]) & 0xFFFFFF80u) | n);
                }
            }
            if (c) {
                const bfu* qrow = qbase + (size_t)tbn * 128 * 8;
#pragma unroll
                for (int ks = 0; ks < 8; ++ks) qf0[ks] = *(const bf16x8*)(qrow + (size_t)(2 * ks) * T_ * 8);
            }
            top16_of_64(v);
#pragma unroll
            for (int i = 0; i < 16; ++i) { float lo, hi2; swap32(v[i], lo, hi2); v[16 + i] = h ? lo : hi2; }
            merge_top16<0, 16>(v);
#pragma unroll
            for (int i = 0; i < 16; ++i) top[c][i] = v[i];
        }
        float cd[64];
        {
            unsigned i1[16], i2[16];
#pragma unroll
            for (int i = 0; i < 16; ++i) { i1[i] = (__float_as_uint(top[0][i]) & 127u) << 7; i2[i] = __float_as_uint(top[1][i]) & 127u; }
#define CAND_(i, j) __uint_as_float((__float_as_uint(top[0][i] + top[1][j]) & 0xFFFFC000u) | i1[i] | i2[j])
#pragma unroll
            for (int q = 0; q < 16; ++q) {
                const float a = CAND_(0, q), b = (q < 15) ? CAND_((q < 15 ? q + 1 : 15), 0) : -INFINITY;
                cd[q] = h ? b : a;
            }
            float cx[19];
            {
                int n = 0;
#pragma unroll
                for (int i = 1; i < 8; ++i)
#pragma unroll
                    for (int jj = 1; jj < 8; ++jj)
                        if ((i + 1) * (jj + 1) <= 16) { cx[n] = CAND_(i, jj); ++n; }
            }
#undef CAND_
#pragma unroll
            for (int q = 0; q < 16; ++q) cd[16 + q] = h ? (q < 3 ? cx[16 + q] : -INFINITY) : cx[q];
        }
        sort16_desc<16>(cd);
        merge_top16<0, 16>(cd);
#pragma unroll
        for (int i = 0; i < 16; ++i) { float lo, hi2; swap32(cd[i], lo, hi2); cd[16 + i] = lo; cd[32 + i] = hi2; }
#pragma unroll
        for (int i = 0; i < 16; ++i) cd[i] = fmaxf(cd[16 + i], cd[47 - i]);
        float gsum = 0.f; float gv[16]; int ids[16];
        const float vmax = __uint_as_float(__float_as_uint(top[0][0] + top[1][0]) & 0xFFFFC000u);
#pragma unroll
        for (int i = 0; i < 16; ++i) {
            const unsigned b = __float_as_uint(cd[i]);
            ids[i] = (int)(b & 0x3FFFu);
            gv[i] = __expf(__uint_as_float(b & 0xFFFFC000u) - vmax); gsum += gv[i];
        }
        const float ginv = 1.f / gsum;
        if (h == 0) {
            int4* ip = (int4*)(idx + (size_t)t * 128 + hd * 16);
#pragma unroll
            for (int i = 0; i < 4; ++i) ip[i] = make_int4(ids[4 * i], ids[4 * i + 1], ids[4 * i + 2], ids[4 * i + 3]);
        } else {
            float4* gp = (float4*)(gate + (size_t)t * 128 + hd * 16);
#pragma unroll
            for (int i = 0; i < 4; ++i) gp[i] = make_float4(gv[4 * i] * ginv, gv[4 * i + 1] * ginv, gv[4 * i + 2] * ginv, gv[4 * i + 3] * ginv);
        }
    }
}

struct Params {
    const float* in[19];
    float* out;
    char* ws;
    int ph_lo, ph_hi;
};
constexpr size_t al256(size_t x) { return (x + 255) & ~(size_t)255; }
constexpr size_t WS_BAR = 0;
constexpr size_t WS_A = al256(XCD_BAR_WORDS * 4);
constexpr size_t WS_GI = WS_A + al256((size_t)T_ * D_ * 2);
constexpr size_t WS_GLF = WS_GI + al256((size_t)T_ * 6 * 4);
constexpr size_t WS_IDX = WS_GLF + al256((size_t)T_ * 6 * 4);
constexpr size_t WS_GATE = WS_IDX + al256((size_t)T_ * 128 * 4);
constexpr int NIN = 3200;
constexpr size_t WS_WTIN = WS_GATE + al256((size_t)T_ * 128 * 4);
constexpr size_t WS_WTOUT = WS_WTIN + al256((size_t)DEPTH_ * NIN * D_ * 2);
constexpr size_t WS_WTQ = WS_WTOUT + al256((size_t)DEPTH_ * D_ * D_ * 2);
constexpr size_t WS_TU = WS_WTQ + al256((size_t)DEPTH_ * 2048 * D_ * 2);
constexpr size_t WS_TV = WS_TU + al256((size_t)16384 * D_ * 2);
constexpr size_t WS_SBQ = WS_TV + al256((size_t)16384 * D_ * 2);
constexpr size_t WS_MLQ = WS_SBQ + al256((size_t)3 * T_ * 384 * 2);
constexpr size_t WS_MLO = WS_MLQ + al256((size_t)3 * T_ * 384 * 2);
constexpr size_t WS_SGU = WS_MLO + al256((size_t)T_ * 384 * 2);
constexpr size_t WS_SGV = WS_SGU + al256((size_t)T_ * 256 * 2);
constexpr size_t WS_WLOC = WS_SGV + al256((size_t)T_ * 256 * 2);
constexpr size_t WS_NLOC = WS_WLOC + al256((size_t)48 * 32 * 4096 * 4);
constexpr size_t WS_SCAL = WS_NLOC + al256((size_t)48 * 32 * 64 * 4);
constexpr size_t WS_SGW = WS_SCAL + al256((size_t)48 * 32 * 2 * 4);
constexpr size_t WS_WG = WS_SGW + al256((size_t)DEPTH_ * 4 * 128 * 128 * 2);
constexpr size_t WS_PQ = WS_WG + al256((size_t)DEPTH_ * 12 * 1024 * 4);
constexpr size_t WS_KEYS = WS_PQ + al256((size_t)T_ * 2048 * 2);
constexpr size_t WS_USC = WS_KEYS + al256((size_t)DEPTH_ * 8 * 2 * 128 * 128 * 2);
constexpr size_t WS_VSC = WS_USC + al256(16384 * 4);
constexpr size_t WS_END = WS_VSC + al256(16384 * 4);
constexpr int NPH = 9;
constexpr int LDS_BYTES = 16 + GEMM_LDS;
static_assert(MLB_LDS <= GEMM_LDS && MLA_LDS <= GEMM_LDS && SBA_LDS + 32 <= GEMM_LDS, "lds");

__global__ void __launch_bounds__(256, 2) mk_fwd(Params p) {
    extern __shared__ __attribute__((aligned(16))) char lds[];
    if (threadIdx.x == 0) *(uint4*)lds = make_uint4(0u, 0u, 0u, 0u);
    __syncthreads();
    XcdBarrier bar = xcd_barrier_post((unsigned*)(p.ws + WS_BAR), (volatile LAS unsigned*)lds);
    float* sm = (float*)(lds + 16);
    char* smc = lds + 16;
    const int G = gridDim.x, bid = blockIdx.x;
    float* topk = (float*)(p.ws + WS_PQ);
    unsigned char* x8 = (unsigned char*)(p.ws + WS_PQ + ((size_t)64 << 20));
    unsigned char* wt8 = (unsigned char*)(p.ws + WS_WTQ);
    bfu* bufA = (bfu*)(p.ws + WS_A);
    float* gi = (float*)(p.ws + WS_GI); float* glf = (float*)(p.ws + WS_GLF);
    int* idx = (int*)(p.ws + WS_IDX); float* gate = (float*)(p.ws + WS_GATE);
    bfu* wtin = (bfu*)(p.ws + WS_WTIN); bfu* wtout = (bfu*)(p.ws + WS_WTOUT); bfu* wtq = (bfu*)(p.ws + WS_WTQ);
    unsigned char* tu = (unsigned char*)(p.ws + WS_TU); unsigned char* tv = (unsigned char*)(p.ws + WS_TV); float* usc = (float*)(p.ws + WS_USC); float* vsc = (float*)(p.ws + WS_VSC);
    bfu* sbq = (bfu*)(p.ws + WS_SBQ); bfu* sbk = sbq + (size_t)T_ * 384; bfu* sbv = sbk + (size_t)T_ * 384;
    bfu* mlq = (bfu*)(p.ws + WS_MLQ); bfu* mlk = mlq + (size_t)T_ * 384; bfu* mlv = mlk + (size_t)T_ * 384;
    bfu* mlo = (bfu*)(p.ws + WS_MLO); bfu* sgu = (bfu*)(p.ws + WS_SGU); bfu* sgv = (bfu*)(p.ws + WS_SGV);
    float* wloc = (float*)(p.ws + WS_WLOC); float* nloc = (float*)(p.ws + WS_NLOC); float* scal = (float*)(p.ws + WS_SCAL);
    bfu* sgw = (bfu*)(p.ws + WS_SGW); float* wgc = (float*)(p.ws + WS_WG);
    float* xo = p.out;
    const int lo = p.ph_lo, hi = p.ph_hi;
#ifndef DUP_MASK
#define DUP_MASK 0
#endif
#define DUPK(ph) ((ph) == 0 ? 0 : 1 + ((ph) - 1) % NPH)
#define PHASE_ID(ph, NB, ...) { const int ph_ = (ph); if (lo <= ph_ && ph_ < hi) { for (int rep_ = 0; rep_ <= ((DUP_MASK >> DUPK(ph_)) & 1); ++rep_) for (int vb = bid; vb < (NB); vb += G) { __VA_ARGS__; } if (ph_ + 1 < hi) xcd_barrier(bar); } }
#define PHASE(k, NB, ...) PHASE_ID(1 + l * NPH + (k), NB, __VA_ARGS__)
#define GEMM_PHASE(k, NTT, NFT, TOKA, AP, BP, RSA, KTSA, RSB, KTSB, ...) { const int ph_ = 1 + l * NPH + (k); if (lo <= ph_ && ph_ < hi) { \
        __VA_ARGS__; const UnitMap um_{bid & 7, (NTT), (NFT), (TOKA)}; const OpLay ol_{(RSA), (KTSA), (RSB), (KTSB)}; \
        for (int rep_ = 0; rep_ <= ((DUP_MASK >> DUPK(ph_)) & 1); ++rep_) gemm_stream<false>((AP), (BP), smc, e, um_, ol_, bid >> 3, G >> 3); \
        if (ph_ + 1 < hi) xcd_barrier(bar); } }
    PHASE_ID(0, DEPTH_ * (800 + 256) + 128 + 16 + 512, {
        if (vb < DEPTH_ * 1056) {
            const int l = vb / 1056, u = vb % 1056;
            if (u < 800) d_transpose_w<true>(u, p.in[2] + (size_t)l * D_ * INW, wtin + (size_t)l * NIN * D_, INW, 50, sm);
            else d_transpose_w<false>(u - 800, p.in[13] + (size_t)l * D_ * D_, wtout + (size_t)l * D_ * D_, D_, 16, sm);
        } else if (vb < DEPTH_ * 1056 + 128) d_cvt_sgw(vb - DEPTH_ * 1056, p.in[10], sgw);
        else if (vb < DEPTH_ * 1056 + 144) d_gatew(vb - DEPTH_ * 1056 - 128, p.in[2], wgc);
        else d_compose_wq(vb - DEPTH_ * 1056 - 144, p.in[15], p.in[16], wtq);
    })
    for (int l = 0; l < DEPTH_; ++l) {
        const float* xcur = (l == 0) ? p.in[0] : xo;
        const float* og = p.in[12] + (size_t)l * D_;
        const float* cw = p.in[5] + (size_t)l * 4 * 768; const float* cb = p.in[6] + l * 768;
        {
            const int ph_ = 1 + l * NPH + 0;
            if (l == 0 && lo <= ph_ && ph_ < hi) {
                __syncthreads();
                for (int e = otid(); e < 3072; e += 256) *(float4*)(sm + e * 4) = *(const float4*)(wgc + (size_t)l * 12288 + e * 4);
                __syncthreads();
                for (int rep_ = 0; rep_ <= ((DUP_MASK >> 1) & 1); ++rep_) for (int vb = bid; vb < T_ / 4; vb += G) d_rmsnorm<true>(vb, xcur, p.in[1] + (size_t)l * D_, bufA, nullptr, sm, p.in[7] + l * 6, p.in[8] + l * 6, gi, glf);
                if (ph_ + 1 < hi) xcd_barrier(bar);
            }
        }
        {
            const int ph_ = 1 + l * NPH + 1;
            if (lo <= ph_ && ph_ < hi) {
                const EpiIn e{p.in[3] + l * 64, p.in[4] + l * 64, p.in[9] + l * 256, sbq, sbk, sbv, mlq, mlk, mlv, mlo, sgu, sgv};
                const UnitMap um_{bid & 7, 16, 25, 0}; const OpLay ol_{32, NIN * 32, 32, T_ * 32};
                for (int rep_ = 0; rep_ <= ((DUP_MASK >> DUPK(ph_)) & 1); ++rep_) gemm_stream<false>(wtin + (size_t)l * NIN * D_, bufA, smc, e, um_, ol_, bid >> 3, G >> 3);
                const int step = G >> 3, maxu = (400 + step - 1) / step, thr = 400 - (maxu - 1) * step;
                int rank = bid, nb = G;
                if (thr < step) { rank = ((bid >> 3) - thr) * 8 + (bid & 7); nb = (step - thr) * 8; }
                if (rank >= 0)
                    for (int vb = rank; vb < 4096; vb += nb) {
                        if (vb < 2048) d_cvt_i4x2<true>(vb, p.in[17] + (size_t)l * 16384 * D_, tu, usc);
                        else d_cvt_i4x2<false>(vb - 2048, p.in[18] + (size_t)l * 16384 * D_, tu + 8, vsc);
                    }
                if (ph_ + 1 < hi) xcd_barrier(bar);
            }
        }
        {
            const int ph_ = 1 + l * NPH + 2;
            if (lo <= ph_ && ph_ < hi) {
                for (int rep_ = 0; rep_ <= ((DUP_MASK >> 3) & 1); ++rep_) {
                for (int j = 0; j * G < 1536; ++j) { const int u = j * G + ((j & 1) ? (G - 1 - bid) : bid); if (u < 1536) d_sb_attn2(u, sbq, sbk, sbv, og, bufA, smc); }
                for (int u = bid; u < 1536; u += G) d_ml_a(u, mlk, mlv, gi, glf, cw, cb, wloc, nloc, scal, smc);
                for (int u = bid; u < 1024; u += G) d_sg2(u, sgu, sgv, sgw + (size_t)l * 4 * 128 * 128, p.in[11] + l * 4 * 128, og, bufA, smc);
                }
                if (ph_ + 1 < hi) xcd_barrier(bar);
            }
        }
        PHASE(3, 1536, d_ml_b(vb, mlq, mlk, mlv, mlo, gi, glf, cw, cb, wloc, nloc, scal, og, bufA, smc))
        GEMM_PHASE(4, 32, 4, 1, bufA, wtout + (size_t)l * D_ * D_, 32, T_ * 32, 32, D_ * 32, const EpiF32<true, false> e{xcur, xo, D_})
        PHASE(5, T_ / 4, d_rmsnorm<false>(vb, xo, p.in[14] + (size_t)l * D_, bufA, x8, nullptr, nullptr, nullptr, nullptr, nullptr))
        {
            const int ph_ = 1 + l * NPH + 6;
            if (lo <= ph_ && ph_ < hi) {
                const EpiScore e{topk}; const UnitMap um_{bid & 7, 16, 16, 0}; const OpLay ol_{32, 2048 * 32, 32, T_ * 32};
                for (int rep_ = 0; rep_ <= ((DUP_MASK >> DUPK(ph_)) & 1); ++rep_)
                    gemm_stream<true>((const bfu*)(wt8 + (size_t)l * 2048 * D_), (const bfu*)x8, smc, e, um_, ol_, bid >> 3, G >> 3);
                if (ph_ + 1 < hi) xcd_barrier(bar);
            }
        }
        PHASE(7, T_ * 8 / 256, d_peer_cand(vb, topk, idx, gate))
        {
            const int ph_ = 1 + l * NPH + 8;
            if (lo <= ph_ && ph_ < hi) {
                if (l + 1 < DEPTH_) {
                    __syncthreads();
                    for (int e = otid(); e < 3072; e += 256) *(float4*)(sm + e * 4) = *(const float4*)(wgc + (size_t)(l + 1) * 12288 + e * 4);
                    __syncthreads();
                    for (int vb = bid; vb < T_ / 4; vb += G)
                        d_peer_expert5<true>(vb, bufA, idx, gate, tu, tv, usc, vsc, xo, p.in[1] + (size_t)(l + 1) * D_, sm, p.in[7] + (l + 1) * 6, p.in[8] + (l + 1) * 6, gi, glf);
                } else {
                    for (int vb = bid; vb < T_ / 4; vb += G) d_peer_expert5<false>(vb, bufA, idx, gate, tu, tv, usc, vsc, xo, nullptr, nullptr, nullptr, nullptr, nullptr, nullptr);
                }
                if (ph_ + 1 < hi) xcd_barrier(bar);
            }
        }
    }
}

extern "C" void kernel_launch(void* const* d_in, const int* in_sizes, int n_in, void* d_out, int out_size, void* d_ws, size_t ws_size, hipStream_t stream) {
    static int grid = 0;
    if (grid == 0) {
        int dev = 0, cus = 0, per_cu = 0;
        (void)hipGetDevice(&dev);
        (void)hipDeviceGetAttribute(&cus, hipDeviceAttributeMultiprocessorCount, dev);
        (void)hipFuncSetAttribute((const void*)mk_fwd, hipFuncAttributeMaxDynamicSharedMemorySize, LDS_BYTES);
        (void)hipOccupancyMaxActiveBlocksPerMultiprocessor(&per_cu, (const void*)mk_fwd, 256, LDS_BYTES);
        if (per_cu < 1) per_cu = 1;
        if (per_cu > 2) per_cu = 2;
        if (cus <= 0) cus = 256;
        grid = cus * per_cu;
        grid -= grid % 8;
        if (grid < 8) grid = 8;
        (void)hipGetLastError();
    }
    if (ws_size < WS_END) return;
    (void)hipMemsetAsync((char*)d_ws + WS_BAR, 0, XCD_BAR_WORDS * 4, stream);
    Params p{};
    for (int i = 0; i < 19; ++i) p.in[i] = (const float*)d_in[i];
    p.out = (float*)d_out; p.ws = (char*)d_ws; p.ph_lo = 0; p.ph_hi = 1 + DEPTH_ * NPH;
    hipLaunchKernelGGL(mk_fwd, dim3(grid), dim3(256), LDS_BYTES, stream, p);
}
```

```cpp
#include <hip/hip_runtime.h>
#include <stdint.h>
#include <math.h>

constexpr int B_ = 8, S_ = 4096, D_ = 1024, T_ = B_ * S_, DEPTH_ = 4;
constexpr int INW = 3212;
constexpr int ZQ = 0, ZK = 384, ZV = 768, ZMQ = 1152, ZMV = 1920, ZMO = 2304, ZMI = 2688, ZMF = 2694, ZSU = 2700, ZSV = 2956;
constexpr float EPS = 1e-6f;

#define XB_TMO      128
#define XB_XCNT(j)  (256  + 64 * (j))
#define XB_XSUB(j)  (1280 + 64 * (j))
#define XB_XGEN(j)  (2304 + 64 * (j))
#define XB_TOP      3328
#define XB_TOPGEN   3392
#define XB_CVT       3456
#define XB_DYN       3712
#define XCD_BAR_WORDS 3776
#define XB_SPIN_CAP (1u << 21)
#define LAS __attribute__((address_space(3)))

__device__ __forceinline__ unsigned xb_ld(unsigned* p)              { return __hip_atomic_load(p, __ATOMIC_RELAXED, __HIP_MEMORY_SCOPE_AGENT); }
__device__ __forceinline__ unsigned xb_add(unsigned* p, unsigned v) { return __hip_atomic_fetch_add(p, v, __ATOMIC_RELAXED, __HIP_MEMORY_SCOPE_AGENT); }
__device__ __forceinline__ unsigned xb_xcc_id() { return (unsigned)__builtin_amdgcn_s_getreg((3 << 11) | 20) & 0xFu; }
#define XB_SPIN(cond, bar) do { unsigned _sp = 0; while (cond) { __builtin_amdgcn_s_sleep(1); \
    if ((++_sp & 255u) == 0u) { if (xb_ld(&(bar)[XB_TMO])) break; if (_sp > XB_SPIN_CAP) { atomicAdd(&(bar)[XB_TMO], 1u); break; } } } } while (0)

struct XcdBarrier {
    unsigned* bar; unsigned x;
    volatile LAS unsigned* st;
};

__device__ __forceinline__ XcdBarrier xcd_barrier_post(unsigned* bar, volatile LAS unsigned* st) {
    XcdBarrier b; b.bar = bar; b.x = xb_xcc_id(); b.st = st;
    if (threadIdx.x == 0) st[2] = xb_add(&bar[XB_XCNT(b.x)], 1u);
    return b;
}
__device__ __forceinline__ void xcd_barrier_complete(unsigned* bar, unsigned x, unsigned& nloc, unsigned& nx) {
    const unsigned G = gridDim.x * gridDim.y * gridDim.z;
    unsigned sum, cnt, mine, sp = 0u;
    for (;;) {
        sum = 0u; cnt = 0u; mine = 0u;
#pragma unroll
        for (unsigned j = 0; j < 16; ++j) { const unsigned c = xb_ld(&bar[XB_XCNT(j)]); sum += c; cnt += (c > 0u) ? 1u : 0u; mine = (j == x) ? c : mine; }
        if (sum == G) break;
        __builtin_amdgcn_s_sleep(1);
        if ((++sp & 255u) == 0u) { if (xb_ld(&bar[XB_TMO])) break; if (sp > XB_SPIN_CAP) { atomicAdd(&bar[XB_TMO], 1u); break; } }
    }
    nloc = mine > 0u ? mine : 1u; nx = cnt > 0u ? cnt : 1u;
}

__device__ __forceinline__ void xcd_barrier(const XcdBarrier& b) {
    asm volatile("s_waitcnt vmcnt(0)" ::: "memory");
    __syncthreads();
    if (threadIdx.x == 0) {
        unsigned* bar = b.bar;
        __builtin_amdgcn_s_waitcnt(0);
        unsigned nloc = b.st[0], nx = b.st[1];
        if (nloc == 0u) { xcd_barrier_complete(bar, b.x, nloc, nx); b.st[0] = nloc; b.st[1] = nx; }
        const unsigned old = xb_add(&bar[XB_XSUB(b.x)], 1u);
        const unsigned gen = old / nloc;
        if (old + 1u == (gen + 1u) * nloc) {
            __builtin_amdgcn_fence(__ATOMIC_RELEASE, "agent");
            asm volatile("s_waitcnt vmcnt(0)" ::: "memory");
            const unsigned og = xb_add(&bar[XB_TOP], 1u);
            const unsigned tg = og / nx;
            if (og + 1u == (tg + 1u) * nx) xb_add(&bar[XB_TOPGEN], 1u);
            else XB_SPIN(xb_ld(&bar[XB_TOPGEN]) == tg, bar);
            __builtin_amdgcn_fence(__ATOMIC_ACQUIRE, "agent");
            xb_add(&bar[XB_XGEN(b.x)], 1u);
            asm volatile("s_waitcnt vmcnt(0)" ::: "memory");
        } else {
            XB_SPIN(xb_ld(&bar[XB_XGEN(b.x)]) == gen, bar);
            __builtin_amdgcn_fence(__ATOMIC_ACQUIRE, "agent");
            asm volatile("s_waitcnt vmcnt(0)" ::: "memory");
        }
    }
    __syncthreads();
}
__device__ __forceinline__ void grp_barrier(const XcdBarrier& b, const bool uni) {
    if (!uni) { xcd_barrier(b); return; }
    asm volatile("s_waitcnt vmcnt(0)" ::: "memory");
    __syncthreads();
    if (threadIdx.x == 0) {
        unsigned* bar = b.bar;
        __builtin_amdgcn_s_waitcnt(0);
        const unsigned nloc = b.st[0];
        const unsigned old = xb_add(&bar[XB_XSUB(b.x)], 1u);
        const unsigned gen = old / nloc;
        if (old + 1u == (gen + 1u) * nloc) xb_add(&bar[XB_XGEN(b.x)], 1u);
        else XB_SPIN(xb_ld(&bar[XB_XGEN(b.x)]) == gen, bar);
        __builtin_amdgcn_fence(__ATOMIC_ACQUIRE, "agent");
        asm volatile("s_waitcnt vmcnt(0)" ::: "memory");
    }
    __syncthreads();
}


__device__ __forceinline__ int otid() { int t = threadIdx.x; asm volatile("" : "+v"(t)); return t; }
template <int CTRL> __device__ __forceinline__ float dpp_f(float x) { return __int_as_float(__builtin_amdgcn_update_dpp(0, __float_as_int(x), CTRL, 0xF, 0xF, true)); }
__device__ __forceinline__ float wave_sum(float v) {
    v += dpp_f<0xB1>(v); v += dpp_f<0x4E>(v); v += dpp_f<0x124>(v); v += dpp_f<0x128>(v);
    { auto r = __builtin_amdgcn_permlane16_swap(__float_as_uint(v), __float_as_uint(v), false, false); v = __uint_as_float(r[0]) + __uint_as_float(r[1]); }
    { auto r = __builtin_amdgcn_permlane32_swap(__float_as_uint(v), __float_as_uint(v), false, false); v = __uint_as_float(r[0]) + __uint_as_float(r[1]); }
    return v;
}
__device__ __forceinline__ float wave_max(float v) {
    v = fmaxf(v, dpp_f<0xB1>(v)); v = fmaxf(v, dpp_f<0x4E>(v)); v = fmaxf(v, dpp_f<0x124>(v)); v = fmaxf(v, dpp_f<0x128>(v));
    { auto r = __builtin_amdgcn_permlane16_swap(__float_as_uint(v), __float_as_uint(v), false, false); v = fmaxf(__uint_as_float(r[0]), __uint_as_float(r[1])); }
    { auto r = __builtin_amdgcn_permlane32_swap(__float_as_uint(v), __float_as_uint(v), false, false); v = fmaxf(__uint_as_float(r[0]), __uint_as_float(r[1])); }
    return v;
}
__device__ __forceinline__ float gelu_tanh(float x) {
    const float u2 = 1.5957691216057308f * (x + 0.044715f * x * x * x);
    return x * __builtin_amdgcn_rcpf(1.f + __expf(-u2));
}
__device__ __forceinline__ float softplus_f(float z) { return fmaxf(z, 0.f) + log1pf(expf(-fabsf(z))); }
__device__ __forceinline__ float logsigmoid_f(float z) { return fminf(z, 0.f) - log1pf(expf(-fabsf(z))); }

typedef __attribute__((ext_vector_type(8))) short bf16x8;
typedef __attribute__((ext_vector_type(4))) short s16x4;
typedef __attribute__((ext_vector_type(16))) float f32x16;
typedef __attribute__((ext_vector_type(4))) unsigned u32x4;
typedef unsigned short bfu;
#define MFMA32(a, b, c) __builtin_amdgcn_mfma_f32_32x32x16_bf16((a), (b), (c), 0, 0, 0)
__device__ __forceinline__ unsigned pk2(float a, float b) {
    typedef __attribute__((ext_vector_type(2))) __bf16 bf2_t;
    typedef __attribute__((ext_vector_type(2))) float f2_t;
    f2_t v = {a, b};
    return __builtin_bit_cast(unsigned, __builtin_convertvector(v, bf2_t));
}
__device__ __forceinline__ bfu f2bf(float a) { return (bfu)(pk2(a, 0.f) & 0xffffu); }
__device__ __forceinline__ float bf2f(bfu b) { return __uint_as_float((unsigned)b << 16); }
__device__ __forceinline__ float bflo(unsigned u) { return __uint_as_float(u << 16); }
__device__ __forceinline__ float bfhi(unsigned u) { return __uint_as_float(u & 0xffff0000u); }
__device__ __forceinline__ int crow(int r, int hi) { return (r & 3) + 8 * (r >> 2) + 4 * hi; }
__device__ __forceinline__ size_t act_off(const size_t t, const int c) { return ((size_t)(c >> 5) * T_ + t) * 32 + (c & 31); }
constexpr float QSCALE_ = 0.125f * 1.4426950408889634f;
__device__ __forceinline__ void swap32(float x, float& lo, float& hi) {
    auto rr = __builtin_amdgcn_permlane32_swap(__float_as_uint(x), __float_as_uint(x), false, false);
    lo = __uint_as_float(rr[0]); hi = __uint_as_float(rr[1]);
}

template <bool REMAP>
__device__ __forceinline__ void d_transpose_w(const int vb, const float* __restrict__ w, bfu* __restrict__ wt, int ldw, int ntn, float* sm) {
    const int tn = vb % ntn, tk = vb / ntn, tid = otid();
    __syncthreads();
#pragma unroll
    for (int i = 0; i < 16; ++i) {
        const int k = i * 4 + (tid >> 6), n = tid & 63; int oc = tn * 64 + n; if (REMAP && oc >= 2688) oc += 12;
        sm[k * 65 + n] = w[(size_t)(tk * 64 + k) * ldw + oc];
    }
    __syncthreads();
#pragma unroll
    for (int i = 0; i < 16; ++i) {
        const int n = i * 4 + (tid >> 6), k = tid & 63;
        wt[((size_t)((tk * 64 + k) >> 5) * (ntn * 64) + tn * 64 + n) * 32 + (k & 31)] = f2bf(sm[k * 65 + n]);
    }
}

constexpr int GEMM_LDS = 73728;
struct UnitMap {
    int grp, NTT, NFT, tok_is_a;
    __device__ __forceinline__ void get(const int L, int& a0, int& b0) const {
        const int ttile = grp * NTT + (L / (8 * NFT)) * 8 + (L & 7), ftile = (L % (8 * NFT)) >> 3;
        if (tok_is_a) { a0 = ttile * 128; b0 = ftile * 256; } else { a0 = ftile * 128; b0 = ttile * 256; }
    }
};
struct OpLay { int rsA, ktsA, rsB, ktsB; };
typedef __attribute__((ext_vector_type(8))) int i32x8;
template <bool FP8, int WT, class Epi>
__device__ __forceinline__ void gemm_stream(const bfu* __restrict__ Ag, const bfu* __restrict__ Bg, char* lds, const Epi& epi, const UnitMap um, const OpLay ol, const int L0, const int step) {
    constexpr int K = D_, KT = FP8 ? K / 64 : K / 32, STG = 24576;
    const int total = um.NTT * um.NFT;
    if (L0 >= total) return;
    const int tid = otid(), lane = tid & 63, wid = __builtin_amdgcn_readfirstlane(tid >> 6), wa = WT ? 0 : wid >> 1, wb = WT ? wid : wid & 1, r = lane & 31, h = lane >> 5;
    constexpr int NI = WT ? 4 : 2, NJ = WT ? 2 : 4, WBR = WT ? 64 : 128;
    const int srow = tid >> 2, sch = (tid & 3) ^ ((srow >> 2) & 3);
    const size_t lane_offA = (size_t)srow * ol.rsA + sch * 8, lane_offB = (size_t)srow * ol.rsB + sch * 8;
#define GDMA(AP, BP, kt, buf) { _Pragma("unroll") for (int j = 0; j < 2; ++j) \
        __builtin_amdgcn_global_load_lds((const unsigned*)((AP) + (size_t)(64 * j) * ol.rsA + (size_t)(kt) * ol.ktsA), (LAS unsigned*)(lds + (buf) * STG + j * 4096 + tid * 16), 16, 0, 0); \
    _Pragma("unroll") for (int j = 0; j < 4; ++j) \
        __builtin_amdgcn_global_load_lds((const unsigned*)((BP) + (size_t)(64 * j) * ol.rsB + (size_t)(kt) * ol.ktsB), (LAS unsigned*)(lds + (buf) * STG + 8192 + j * 4096 + tid * 16), 16, 0, 0); }
    int L = L0, a0, b0;
    um.get(L, a0, b0);
    const bfu* ap = Ag + (size_t)a0 * ol.rsA + lane_offA;
    const bfu* bp = Bg + (size_t)b0 * ol.rsB + lane_offB;
    __syncthreads();
    GDMA(ap, bp, 0, 0); GDMA(ap, bp, 1, 1);
    const int sw = (r >> 2) & 3;
    const int aoff = (wa * 64 + r) * 64, boff = 8192 + (wb * WBR + r) * 64;
    int cur = 0, nxt2 = 2;
    asm volatile("s_waitcnt vmcnt(0)" ::: "memory");
    __builtin_amdgcn_s_barrier();
#pragma unroll 1
    for (;;) {
        const int Ln = L + step; const bool has_next = Ln < total;
        int a0n = a0, b0n = b0; if (has_next) um.get(Ln, a0n, b0n);
        const bfu* apn = Ag + (size_t)a0n * ol.rsA + lane_offA;
        const bfu* bpn = Bg + (size_t)b0n * ol.rsB + lane_offB;
        f32x16 acc[NI][NJ];
#pragma unroll
        for (int i = 0; i < NI; ++i)
#pragma unroll
            for (int j = 0; j < NJ; ++j)
#pragma unroll
                for (int e = 0; e < 16; ++e) acc[i][j][e] = 0.f;
#pragma unroll 1
        for (int kt = 0; kt < KT; ++kt) {
            const char* lb = lds + cur * STG;
            bf16x8 af[2][NI], bf[2][NJ];
            {
                const int co = ((FP8 ? 2 * h : h) ^ sw) << 4;
#pragma unroll
                for (int i = 0; i < NI; ++i) af[0][i] = *(const bf16x8*)(lb + aoff + i * 2048 + co);
#pragma unroll
                for (int j = 0; j < NJ; ++j) bf[0][j] = *(const bf16x8*)(lb + boff + j * 2048 + co);
            }
            if (!FP8) __builtin_amdgcn_sched_barrier(0);
            {
                const int co = ((FP8 ? 2 * h + 1 : 2 + h) ^ sw) << 4;
#pragma unroll
                for (int i = 0; i < NI; ++i) af[1][i] = *(const bf16x8*)(lb + aoff + i * 2048 + co);
#pragma unroll
                for (int j = 0; j < NJ; ++j) bf[1][j] = *(const bf16x8*)(lb + boff + j * 2048 + co);
            }
            const bool in_unit = kt + 2 < KT;
            const bfu* apc = in_unit ? ap : apn; const bfu* bpc = in_unit ? bp : bpn;
            const int ktn = in_unit ? kt + 2 : (has_next ? kt + 2 - KT : KT - 1);
            if (FP8) __builtin_amdgcn_sched_barrier(0);
            GDMA(apc, bpc, ktn, nxt2);
            if (FP8) {
#pragma unroll
                for (int i = 0; i < NI; ++i)
#pragma unroll
                    for (int j = 0; j < NJ; ++j) {
                        const i32x8 a8 = __builtin_bit_cast(i32x8, __builtin_shufflevector(af[0][i], af[1][i], 0, 1, 2, 3, 4, 5, 6, 7, 8, 9, 10, 11, 12, 13, 14, 15));
                        const i32x8 b8 = __builtin_bit_cast(i32x8, __builtin_shufflevector(bf[0][j], bf[1][j], 0, 1, 2, 3, 4, 5, 6, 7, 8, 9, 10, 11, 12, 13, 14, 15));
                        acc[i][j] = __builtin_amdgcn_mfma_scale_f32_32x32x64_f8f6f4(a8, b8, acc[i][j], 0, 0, 0, 0x7F7F7F7F, 0, 0x7F7F7F7F);
                    }
#pragma unroll
                for (int g = 0; g < 6; ++g) { __builtin_amdgcn_sched_group_barrier(0x010, 1, 0); __builtin_amdgcn_sched_group_barrier(0x008, 1, 0); }
                __builtin_amdgcn_sched_group_barrier(0x008, 2, 0);
            } else {
#pragma unroll
                for (int ks = 0; ks < 2; ++ks)
#pragma unroll
                    for (int i = 0; i < NI; ++i)
#pragma unroll
                        for (int j = 0; j < NJ; ++j) acc[i][j] = MFMA32(af[ks][i], bf[ks][j], acc[i][j]);
#pragma unroll
                for (int g = 0; g < 6; ++g) { __builtin_amdgcn_sched_group_barrier(0x008, 1, 0); __builtin_amdgcn_sched_group_barrier(0x100, 1, 0); }
                __builtin_amdgcn_sched_group_barrier(0x008, 2, 0);
#pragma unroll
                for (int g = 0; g < 6; ++g) { __builtin_amdgcn_sched_group_barrier(0x010, 1, 0); __builtin_amdgcn_sched_group_barrier(0x008, 1, 0); }
                __builtin_amdgcn_sched_group_barrier(0x008, 2, 0);
            }
            __builtin_amdgcn_sched_barrier(0);
            if (kt + 1 < KT) { asm volatile("s_waitcnt vmcnt(6)" ::: "memory"); __builtin_amdgcn_s_barrier(); }
            cur = (cur == 2) ? 0 : cur + 1; nxt2 = (nxt2 == 2) ? 0 : nxt2 + 1;
        }
        asm volatile("s_waitcnt vmcnt(0)" ::: "memory");
        __builtin_amdgcn_s_barrier();
        epi(acc, a0 + wa * 64, b0 + wb * WBR, r, h, lds + nxt2 * STG, wa, wb);
        if (!has_next) break;
        L = Ln; a0 = a0n; b0 = b0n; ap = apn; bp = bpn;
    }
    asm volatile("s_waitcnt vmcnt(0)" ::: "memory");
#undef GDMA
}
template <int CTRL> __device__ __forceinline__ float dppq_f(float x) { return __int_as_float(__builtin_amdgcn_update_dpp(0, __float_as_int(x), CTRL, 0xF, 0xF, true)); }
__device__ __forceinline__ void quad_transpose4(float& a0, float& a1, float& a2, float& a3, const int q) {
    const bool b0 = q & 1, b1 = q & 2;
    { const float s = b0 ? a0 : a1, t = dppq_f<0xB1>(s); if (b0) a0 = t; else a1 = t; }
    { const float s = b0 ? a2 : a3, t = dppq_f<0xB1>(s); if (b0) a2 = t; else a3 = t; }
    { const float s = b1 ? a0 : a2, t = dppq_f<0x4E>(s); if (b1) a0 = t; else a2 = t; }
    { const float s = b1 ? a1 : a3, t = dppq_f<0x4E>(s); if (b1) a1 = t; else a3 = t; }
}
template <bool RES, bool REMAP>
struct EpiF32 {
    const float* R; float* C; int ldc;
    __device__ __forceinline__ void operator()(f32x16 (&acc)[2][4], int abase, int bbase, int r, int h, char* xl, int wa, int wb) const {
        if (REMAP) {
#pragma unroll
            for (int i = 0; i < 2; ++i)
#pragma unroll
                for (int j = 0; j < 4; ++j) {
                    int col = bbase + j * 32 + r; if (col >= 2688) col += 12;
#pragma unroll
                    for (int e = 0; e < 16; ++e) {
                        const size_t o = (size_t)(abase + i * 32 + crow(e, h)) * ldc + col;
                        C[o] = acc[i][j][e] + (RES ? R[o] : 0.f);
                    }
                }
        } else {
            const int q = r & 3;
#pragma unroll
            for (int i = 0; i < 2; ++i)
#pragma unroll
                for (int j = 0; j < 4; ++j) {
                    const int col = bbase + j * 32 + (r & ~3);
#pragma unroll
                    for (int g = 0; g < 4; ++g) {
                        float a0 = acc[i][j][4 * g], a1 = acc[i][j][4 * g + 1], a2 = acc[i][j][4 * g + 2], a3 = acc[i][j][4 * g + 3];
                        quad_transpose4(a0, a1, a2, a3, q);
                        const size_t o = (size_t)(abase + i * 32 + 8 * g + 4 * h + q) * ldc + col;
                        float4 v = make_float4(a0, a1, a2, a3);
                        if (RES) { const float4 rv = *(const float4*)(R + o); v.x += rv.x; v.y += rv.y; v.z += rv.z; v.w += rv.w; }
                        *(float4*)(C + o) = v;
                    }
                }
        }
    }
};

struct EpiOut {
    const float* R; float* C; bfu* XB; unsigned char* X8;
    __device__ __forceinline__ void operator()(f32x16 (&acc)[2][4], int abase, int bbase, int r, int h, char* xl, int wa, int wb) const {
        const int q = r & 3;
#pragma unroll
        for (int i = 0; i < 2; ++i)
#pragma unroll
            for (int j = 0; j < 4; ++j) {
                const int col = bbase + j * 32 + (r & ~3);
                bfu* xb = XB + ((size_t)(col >> 5) * T_) * 32 + (col & 31);
                unsigned char* x8 = X8 + ((size_t)(col >> 6) * T_) * 64 + (col & 63);
#pragma unroll
                for (int g = 0; g < 4; ++g) {
                    float a0 = acc[i][j][4 * g], a1 = acc[i][j][4 * g + 1], a2 = acc[i][j][4 * g + 2], a3 = acc[i][j][4 * g + 3];
                    quad_transpose4(a0, a1, a2, a3, q);
                    const int row = abase + i * 32 + 8 * g + 4 * h + q;
                    const size_t o = (size_t)row * D_ + col;
                    const float4 rv = *(const float4*)(R + o);
                    const float4 v = make_float4(a0 + rv.x, a1 + rv.y, a2 + rv.z, a3 + rv.w);
                    *(float4*)(C + o) = v;
                    *(uint2*)(xb + (size_t)row * 32) = make_uint2(pk2(v.x, v.y), pk2(v.z, v.w));
                    int w8 = __builtin_amdgcn_cvt_pk_fp8_f32(v.x, v.y, 0, false);
                    w8 = __builtin_amdgcn_cvt_pk_fp8_f32(v.z, v.w, w8, true);
                    *(int*)(x8 + (size_t)row * 64) = w8;
                }
            }
    }
};

template <bool GATES>
__device__ __forceinline__ void d_rmsnorm(const int vb, const float* __restrict__ x, const float* __restrict__ g, bfu* __restrict__ out, unsigned char* __restrict__ out8,
                                          const float* swg, const float* __restrict__ ib, const float* __restrict__ fb, float* __restrict__ gi, float* __restrict__ glf) {
    const int row = vb * 4 + (otid() >> 6), lane = otid() & 63;
    const float4* xr = (const float4*)(x + (size_t)row * D_);
    const float4* g4 = (const float4*)g;
    float4 v[4]; float ss = 0.f;
#pragma unroll
    for (int i = 0; i < 4; ++i) { v[i] = xr[lane + 64 * i]; ss += v[i].x * v[i].x + v[i].y * v[i].y + v[i].z * v[i].z + v[i].w * v[i].w; }
    ss = wave_sum(ss);
    const float r = rsqrtf(ss * (1.f / D_) + EPS);
#pragma unroll
    for (int i = 0; i < 4; ++i) {
        const float4 gg = g4[lane + 64 * i];
        v[i].x *= r * gg.x; v[i].y *= r * gg.y; v[i].z *= r * gg.z; v[i].w *= r * gg.w;
        *(uint2*)(out + act_off(row, (lane + 64 * i) * 4)) = make_uint2(pk2(v[i].x, v[i].y), pk2(v[i].z, v[i].w));
        if (!GATES) {
            int w8 = __builtin_amdgcn_cvt_pk_fp8_f32(v[i].x, v[i].y, 0, false);
            w8 = __builtin_amdgcn_cvt_pk_fp8_f32(v[i].z, v[i].w, w8, true);
            const int col = (lane + 64 * i) * 4;
            *(int*)(out8 + ((size_t)(col >> 6) * T_ + row) * 64 + (col & 63)) = w8;
        }
    }
    if (GATES) {
        float mine = 0.f;
#pragma unroll
        for (int j = 0; j < 12; ++j) {
            float part = 0.f;
#pragma unroll
            for (int i = 0; i < 4; ++i) { const float4 w = *(const float4*)(swg + j * 1024 + (lane + 64 * i) * 4); part += v[i].x * w.x + v[i].y * w.y + v[i].z * w.z + v[i].w * w.w; }
            part = wave_sum(part);
            if (lane == j) mine = part;
        }
        const int b = row / S_, s = row % S_;
        if (lane < 6) gi[((size_t)b * 6 + lane) * S_ + s] = mine + ib[lane];
        else if (lane < 12) glf[((size_t)b * 6 + lane - 6) * S_ + s] = logsigmoid_f(mine + fb[lane - 6]);
    }
}
__device__ __forceinline__ void d_gatew(const int vb, const float* __restrict__ w_in, float* __restrict__ wg) {
    const int l = vb >> 2, k = (vb & 3) * 256 + otid();
    const float* src = w_in + ((size_t)l * D_ + k) * INW + ZMI;
    const float4 a = *(const float4*)src, b = *(const float4*)(src + 4), c = *(const float4*)(src + 8);
    const float v[12] = {a.x, a.y, a.z, a.w, b.x, b.y, b.z, b.w, c.x, c.y, c.z, c.w};
#pragma unroll
    for (int j = 0; j < 12; ++j) wg[((size_t)l * 12 + j) * 1024 + k] = v[j];
}

struct EpiBf16T {
    bfu* O; int ldo;
    __device__ __forceinline__ void operator()(f32x16 (&acc)[2][4], int abase, int bbase, int r, int h, char* xl, int wa, int wb) const {
#pragma unroll
        for (int j = 0; j < 4; ++j) {
            bfu* op = O + ((size_t)(abase >> 3) * T_ + (bbase + j * 32 + r)) * 8 + 4 * h;
#pragma unroll
            for (int i = 0; i < 2; ++i)
#pragma unroll
                for (int g = 0; g < 4; ++g)
                    *(uint2*)(op + (size_t)(4 * i + g) * T_ * 8) = make_uint2(pk2(acc[i][j][4 * g], acc[i][j][4 * g + 1]), pk2(acc[i][j][4 * g + 2], acc[i][j][4 * g + 3]));
        }
    }
};

struct EpiIn {
    const float* qg; const float* kg; const float* vng;
    bfu *sbq, *sbk, *sbv, *mlq, *mlk, *mlv, *mlo, *sgu, *sgv;
    __device__ __forceinline__ void operator()(f32x16 (&acc)[2][4], int abase, int bbase, int r, int h, char* xl, int wa, int wb) const {
        const int cb = __builtin_amdgcn_readfirstlane(abase >> 6);
#pragma unroll
        for (int j = 0; j < 4; ++j) {
            const int t = bbase + j * 32 + r, b = t >> 12, s = t & 4095;
            bfu* dst; float sc = 1.f; const float* gn = nullptr; size_t cst = (size_t)S_ * 8;
            if (cb < 6) { dst = sbq + (((size_t)b * 6 + cb) * 8 * S_ + s) * 8; gn = qg; sc = QSCALE_; }
            else if (cb < 12) { dst = sbk + (((size_t)b * 6 + cb - 6) * 8 * S_ + s) * 8; gn = kg; }
            else if (cb < 18) dst = sbv + (((size_t)b * 6 + cb - 12) * 8 * S_ + s) * 8;
            else if (cb < 24) dst = mlq + (((size_t)b * 6 + cb - 18) * 8 * S_ + s) * 8;
            else if (cb < 30) dst = mlk + (((size_t)b * 6 + cb - 24) * 8 * S_ + s) * 8;
            else if (cb < 36) dst = mlv + (((size_t)b * 6 + cb - 30) * 8 * S_ + s) * 8;
            else if (cb < 42) { dst = mlo + ((size_t)(cb - 36) * 8 * T_ + t) * 8; cst = (size_t)T_ * 8; }
            else if (cb < 46) { dst = sgu + ((size_t)(cb - 42) * 8 * T_ + t) * 8; cst = (size_t)T_ * 8; }
            else { dst = sgv + (((size_t)b * 4 + cb - 46) * 8 * S_ + s) * 8; gn = vng + (cb - 46) * 64; }
            if (cb >= 36 && cb < 42) {
#pragma unroll
                for (int i = 0; i < 2; ++i)
#pragma unroll
                    for (int e = 0; e < 16; ++e) acc[i][j][e] = __builtin_amdgcn_rcpf(1.f + __expf(-acc[i][j][e]));
            } else if (cb >= 42) {
#pragma unroll
                for (int i = 0; i < 2; ++i)
#pragma unroll
                    for (int e = 0; e < 16; ++e) acc[i][j][e] = gelu_tanh(acc[i][j][e]);
            }
            if (gn) {
                float ss = 0.f;
#pragma unroll
                for (int i = 0; i < 2; ++i)
#pragma unroll
                    for (int e = 0; e < 16; ++e) ss += acc[i][j][e] * acc[i][j][e];
                float lo, hi2; swap32(ss, lo, hi2);
                const float rinv = rsqrtf((lo + hi2) * (1.f / 64) + EPS) * sc;
#pragma unroll
                for (int i = 0; i < 2; ++i)
#pragma unroll
                    for (int g = 0; g < 4; ++g) {
                        const float4 g4 = *(const float4*)(gn + i * 32 + 8 * g + 4 * h);
                        acc[i][j][4 * g] *= rinv * g4.x; acc[i][j][4 * g + 1] *= rinv * g4.y; acc[i][j][4 * g + 2] *= rinv * g4.z; acc[i][j][4 * g + 3] *= rinv * g4.w;
                    }
            }
#pragma unroll
            for (int i = 0; i < 2; ++i)
#pragma unroll
                for (int g = 0; g < 4; g += 2) {
                    const unsigned ax = pk2(acc[i][j][4 * g], acc[i][j][4 * g + 1]), ay = pk2(acc[i][j][4 * g + 2], acc[i][j][4 * g + 3]);
                    const unsigned bx = pk2(acc[i][j][4 * g + 4], acc[i][j][4 * g + 5]), by = pk2(acc[i][j][4 * g + 6], acc[i][j][4 * g + 7]);
                    const auto rx = __builtin_amdgcn_permlane32_swap(ax, bx, false, false), ry = __builtin_amdgcn_permlane32_swap(ay, by, false, false);
                    u32x4 o; o[0] = rx[0]; o[1] = ry[0]; o[2] = rx[1]; o[3] = ry[1];
                    *(u32x4*)(dst + (size_t)(4 * i + g + h) * cst) = o;
                }
        }
    }
};

__device__ __forceinline__ void d_cvt_bf16(const int vb, const float* __restrict__ src, bfu* __restrict__ dst) {
    const size_t e = (size_t)vb * 2048 + otid() * 8;
    const float4 a = *(const float4*)(src + e), b = *(const float4*)(src + e + 4);
    u32x4 o; o[0] = pk2(a.x, a.y); o[1] = pk2(a.z, a.w); o[2] = pk2(b.x, b.y); o[3] = pk2(b.z, b.w);
    *(u32x4*)(dst + e) = o;
}
typedef __attribute__((ext_vector_type(2))) __bf16 bf2_t;
__device__ __forceinline__ float dot2bf(unsigned a, unsigned b, float c) { return __builtin_amdgcn_fdot2_f32_bf16(__builtin_bit_cast(bf2_t, a), __builtin_bit_cast(bf2_t, b), c, false); }
__device__ __forceinline__ void d_peer_expert2(const int vb, const bfu* __restrict__ xn, const int* __restrict__ idx, const float* __restrict__ gate,
                                               const bfu* __restrict__ ut, const bfu* __restrict__ vt, float* x) {
    const int wv = __builtin_amdgcn_readfirstlane(otid() >> 6), lane = otid() & 63;
    const int t = vb * 4 + wv;
    const u32x4* xr = (const u32x4*)(xn + (size_t)t * D_);
    const u32x4 xp0 = xr[lane], xp1 = xr[lane + 64];
    float y[16];
#pragma unroll
    for (int i = 0; i < 16; ++i) y[i] = 0.f;
    const int* ip = idx + (size_t)t * 128; const float* gp = gate + (size_t)t * 128;
#pragma unroll 1
    for (int e0 = 0; e0 < 128; e0 += 8) {
        u32x4 u0[8], u1[8], v0[8], v1[8]; float a[8], g[8];
#pragma unroll
        for (int j = 0; j < 8; ++j) {
            const int id = ip[e0 + j]; g[j] = gp[e0 + j];
            const u32x4* ur = (const u32x4*)(ut + (size_t)id * D_); u0[j] = ur[lane]; u1[j] = ur[lane + 64];
            const u32x4* vr = (const u32x4*)(vt + (size_t)id * D_); v0[j] = vr[lane]; v1[j] = vr[lane + 64];
        }
#pragma unroll
        for (int j = 0; j < 8; ++j) {
            float acc = 0.f;
#pragma unroll
            for (int q = 0; q < 4; ++q) { acc = dot2bf(u0[j][q], xp0[q], acc); acc = dot2bf(u1[j][q], xp1[q], acc); }
            a[j] = acc;
        }
#pragma unroll
        for (int j = 0; j < 8; ++j) a[j] = wave_sum(a[j]);
#pragma unroll
        for (int j = 0; j < 8; ++j) {
            const float w = gelu_tanh(a[j]) * g[j];
#pragma unroll
            for (int q = 0; q < 4; ++q) {
                y[2 * q] += w * bflo(v0[j][q]); y[2 * q + 1] += w * bfhi(v0[j][q]);
                y[8 + 2 * q] += w * bflo(v1[j][q]); y[8 + 2 * q + 1] += w * bfhi(v1[j][q]);
            }
        }
    }
    float4* xo = (float4*)(x + (size_t)t * D_);
#pragma unroll
    for (int i = 0; i < 2; ++i) {
        float4 r0 = xo[lane * 2 + 128 * i], r1 = xo[lane * 2 + 128 * i + 1];
        r0.x += y[8 * i]; r0.y += y[8 * i + 1]; r0.z += y[8 * i + 2]; r0.w += y[8 * i + 3];
        r1.x += y[8 * i + 4]; r1.y += y[8 * i + 5]; r1.z += y[8 * i + 6]; r1.w += y[8 * i + 7];
        xo[lane * 2 + 128 * i] = r0; xo[lane * 2 + 128 * i + 1] = r1;
    }
}

__device__ __forceinline__ void d_cvt_fp8(const int vb, const float* __restrict__ src, unsigned char* __restrict__ dst, float* __restrict__ inv_scale) {
    const int tid = otid(), lane = tid & 63, row = vb * 4 + (tid >> 6);
    const float4* sr = (const float4*)(src + (size_t)row * D_);
    float4 v[4]; float am = 0.f;
#pragma unroll
    for (int i = 0; i < 4; ++i) { v[i] = sr[lane + 64 * i]; am = fmaxf(am, fmaxf(fmaxf(fabsf(v[i].x), fabsf(v[i].y)), fmaxf(fabsf(v[i].z), fabsf(v[i].w)))); }
    am = wave_max(am);
    const float sc = am > 0.f ? 256.f / am : 1.f;
    if (lane == 0) inv_scale[row] = am > 0.f ? am * (1.f / 256.f) : 1.f;
    unsigned* dr = (unsigned*)(dst + (size_t)row * D_);
#pragma unroll
    for (int i = 0; i < 4; ++i) {
        int w = 0;
        w = __builtin_amdgcn_cvt_pk_fp8_f32(v[i].x * sc, v[i].y * sc, w, false);
        w = __builtin_amdgcn_cvt_pk_fp8_f32(v[i].z * sc, v[i].w * sc, w, true);
        dr[lane + 64 * i] = (unsigned)w;
    }
}
typedef __attribute__((ext_vector_type(2))) float f2_t;
__device__ __forceinline__ void d_peer_expert3(const int vb, const bfu* __restrict__ xn, const int* __restrict__ idx, const float* __restrict__ gate,
                                               const unsigned char* __restrict__ ut, const unsigned char* __restrict__ vt, const float* __restrict__ usc, const float* __restrict__ vsc, float* x) {
    const int tid = otid(), lane = tid & 63;
    const int wv = __builtin_amdgcn_readfirstlane(tid >> 6);
    const int t = vb * 4 + wv;
    float xv[16], y[16];
    {
        const u32x4* xr = (const u32x4*)(xn + act_off(t, lane * 16));
        const u32x4 a = xr[0], b = xr[1];
#pragma unroll
        for (int q = 0; q < 4; ++q) { xv[2 * q] = bflo(a[q]); xv[2 * q + 1] = bfhi(a[q]); xv[8 + 2 * q] = bflo(b[q]); xv[8 + 2 * q + 1] = bfhi(b[q]); }
    }
#pragma unroll
    for (int i = 0; i < 16; ++i) y[i] = 0.f;
    const int* ip = idx + (size_t)t * 128; const float* gp = gate + (size_t)t * 128;
#pragma unroll 1
    for (int e0 = 0; e0 < 128; e0 += 16) {
        u32x4 u[16], v[16]; float a[16], g[16];
#pragma unroll
        for (int j = 0; j < 16; ++j) {
            const int id = ip[e0 + j];
            u[j] = *(const u32x4*)(ut + (size_t)id * D_ + lane * 16);
            v[j] = *(const u32x4*)(vt + (size_t)id * D_ + lane * 16);
            a[j] = usc[id]; g[j] = gp[e0 + j] * vsc[id];
        }
#pragma unroll
        for (int j = 0; j < 16; ++j) {
            float acc = 0.f;
#pragma unroll
            for (int q = 0; q < 4; ++q) {
                const f2_t lo = __builtin_amdgcn_cvt_pk_f32_fp8((int)u[j][q], false), hi = __builtin_amdgcn_cvt_pk_f32_fp8((int)u[j][q], true);
                acc += lo[0] * xv[4 * q] + lo[1] * xv[4 * q + 1] + hi[0] * xv[4 * q + 2] + hi[1] * xv[4 * q + 3];
            }
            a[j] *= wave_sum(acc);
        }
#pragma unroll
        for (int j = 0; j < 16; ++j) {
            const float w = gelu_tanh(a[j]) * g[j];
#pragma unroll
            for (int q = 0; q < 4; ++q) {
                const f2_t lo = __builtin_amdgcn_cvt_pk_f32_fp8((int)v[j][q], false), hi = __builtin_amdgcn_cvt_pk_f32_fp8((int)v[j][q], true);
                y[4 * q] += w * lo[0]; y[4 * q + 1] += w * lo[1]; y[4 * q + 2] += w * hi[0]; y[4 * q + 3] += w * hi[1];
            }
        }
    }
    float4* xo = (float4*)(x + (size_t)t * D_ + lane * 16);
#pragma unroll
    for (int i = 0; i < 4; ++i) { float4 r0 = xo[i]; r0.x += y[4 * i]; r0.y += y[4 * i + 1]; r0.z += y[4 * i + 2]; r0.w += y[4 * i + 3]; xo[i] = r0; }
}

__device__ __forceinline__ float row16_allreduce(float x) {
    x += dpp_f<0xB1>(x); x += dpp_f<0x4E>(x); x += dpp_f<0x124>(x); x += dpp_f<0x128>(x); return x;
}
__device__ __forceinline__ void d_peer_expert4(const int vb, const bfu* __restrict__ xn, const int* __restrict__ idx, const float* __restrict__ gate,
                                               const unsigned char* __restrict__ ut, const unsigned char* __restrict__ vt, const float* __restrict__ usc, const float* __restrict__ vsc, float* x) {
    const int tid = otid(), lane = tid & 63;
    const int wv = __builtin_amdgcn_readfirstlane(tid >> 6);
    const int t = vb * 4 + wv;
    float xv[16], y[16];
    {
        const u32x4* xr = (const u32x4*)(xn + act_off(t, lane * 16));
        const u32x4 a = xr[0], b = xr[1];
#pragma unroll
        for (int q = 0; q < 4; ++q) { xv[2 * q] = bflo(a[q]); xv[2 * q + 1] = bfhi(a[q]); xv[8 + 2 * q] = bflo(b[q]); xv[8 + 2 * q + 1] = bfhi(b[q]); }
    }
#pragma unroll
    for (int i = 0; i < 16; ++i) y[i] = 0.f;
    const int* ip = idx + (size_t)t * 128; const float* gp = gate + (size_t)t * 128;
    const int sel = (lane >> 2) & 3;
    const int el = ((lane >> 5) & 1) * 8 + ((lane >> 4) & 1) * 4 + sel;
#pragma unroll 1
    for (int e0 = 0; e0 < 128; e0 += 16) {
        u32x4 u[16], v[16];
#pragma unroll
        for (int j = 0; j < 16; ++j) {
            const int id = ip[e0 + j];
            u[j] = *(const u32x4*)(ut + (size_t)id * D_ + lane * 16);
            v[j] = *(const u32x4*)(vt + (size_t)id * D_ + lane * 16);
        }
        const int myid = ip[e0 + el];
        const float myus = usc[myid], mygs = gp[e0 + el] * vsc[myid];
        float pd[16];
#pragma unroll
        for (int j = 0; j < 16; ++j) {
            float acc = 0.f;
#pragma unroll
            for (int q = 0; q < 4; ++q) {
                const f2_t lo = __builtin_amdgcn_cvt_pk_f32_fp8((int)u[j][q], false), hi = __builtin_amdgcn_cvt_pk_f32_fp8((int)u[j][q], true);
                acc += lo[0] * xv[4 * q] + lo[1] * xv[4 * q + 1] + hi[0] * xv[4 * q + 2] + hi[1] * xv[4 * q + 3];
            }
            pd[j] = acc;
        }
        float q8[8], q4[4];
#pragma unroll
        for (int i = 0; i < 8; ++i) { auto rr = __builtin_amdgcn_permlane32_swap(__float_as_uint(pd[i]), __float_as_uint(pd[i + 8]), false, false); q8[i] = __uint_as_float(rr[0]) + __uint_as_float(rr[1]); }
#pragma unroll
        for (int i = 0; i < 4; ++i) { auto rr = __builtin_amdgcn_permlane16_swap(__float_as_uint(q8[i]), __float_as_uint(q8[i + 4]), false, false); q4[i] = row16_allreduce(__uint_as_float(rr[0]) + __uint_as_float(rr[1])); }
        const float s = sel == 0 ? q4[0] : sel == 1 ? q4[1] : sel == 2 ? q4[2] : q4[3];
        const float w = gelu_tanh(s * myus) * mygs;
#pragma unroll
        for (int j = 0; j < 16; ++j) {
            const float wj = __int_as_float(__builtin_amdgcn_readlane(__float_as_int(w), ((j >> 3) & 1) * 32 + ((j >> 2) & 1) * 16 + (j & 3) * 4));
#pragma unroll
            for (int q = 0; q < 4; ++q) {
                const f2_t lo = __builtin_amdgcn_cvt_pk_f32_fp8((int)v[j][q], false), hi = __builtin_amdgcn_cvt_pk_f32_fp8((int)v[j][q], true);
                y[4 * q] += wj * lo[0]; y[4 * q + 1] += wj * lo[1]; y[4 * q + 2] += wj * hi[0]; y[4 * q + 3] += wj * hi[1];
            }
        }
    }
    float4* xo = (float4*)(x + (size_t)t * D_ + lane * 16);
#pragma unroll
    for (int i = 0; i < 4; ++i) { float4 r0 = xo[i]; r0.x += y[4 * i]; r0.y += y[4 * i + 1]; r0.z += y[4 * i + 2]; r0.w += y[4 * i + 3]; xo[i] = r0; }
}

__device__ __forceinline__ void d_cvt_i4(const int vb, const float* __restrict__ src, unsigned char* __restrict__ dst  , float* __restrict__ step) {
    const int tid = otid(), lane = tid & 63, row = vb * 4 + (tid >> 6);
    const float4* sr = (const float4*)(src + (size_t)row * D_ + lane * 16);
    float v[16]; float am = 0.f, ss = 0.f;
#pragma unroll
    for (int i = 0; i < 4; ++i) { const float4 a = sr[i]; v[4 * i] = a.x; v[4 * i + 1] = a.y; v[4 * i + 2] = a.z; v[4 * i + 3] = a.w; }
#pragma unroll
    for (int i = 0; i < 16; ++i) { am = fmaxf(am, fabsf(v[i])); ss += v[i] * v[i]; }
    ss = wave_sum(ss);
    am = wave_max(am);
    float s = fmaxf(2.5f * sqrtf(ss * (1.f / D_)), am * (1.f / 16.f)) * (1.f / 7.f);
    if (!(s > 0.f)) s = 1.f;
    const float inv = 1.f / s;
    if (lane == 0) step[row] = s;
    unsigned w[2];
#pragma unroll
    for (int d = 0; d < 2; ++d) {
        unsigned acc = 0u;
#pragma unroll
        for (int e = 0; e < 8; ++e) {
            const int q = (int)fminf(fmaxf(rintf(v[8 * d + e] * inv), -8.f), 7.f);
            acc |= (unsigned)((e < 4) ? (q + 8) : (q & 15)) << ((e & 3) * 8 + (e >> 2) * 4);
        }
        w[d] = acc;
    }
    *(uint2*)(dst + (size_t)row * 1024 + lane * 16) = make_uint2(w[0], w[1]);
}
template <bool UENC>
__device__ __forceinline__ void d_cvt_i4x2(const int vb, const float* __restrict__ src, unsigned char* __restrict__ dst, float* __restrict__ step, const float* __restrict__ gfold) {
    const int tid = otid(), lane = tid & 63, row0 = vb * 8 + (tid >> 6) * 2;
    float v[2][16];
#pragma unroll
    for (int rr = 0; rr < 2; ++rr) {
        const float4* sr = (const float4*)(src + (size_t)(row0 + rr) * D_ + lane * 16);
#pragma unroll
        for (int i = 0; i < 4; ++i) { const float4 a = sr[i]; v[rr][4 * i] = a.x; v[rr][4 * i + 1] = a.y; v[rr][4 * i + 2] = a.z; v[rr][4 * i + 3] = a.w; }
    }
    if (UENC) {
        const float4* gq = (const float4*)(gfold + lane * 16);
#pragma unroll
        for (int i = 0; i < 4; ++i) {
            const float4 g4 = gq[i];
#pragma unroll
            for (int rr = 0; rr < 2; ++rr) { v[rr][4 * i] *= g4.x; v[rr][4 * i + 1] *= g4.y; v[rr][4 * i + 2] *= g4.z; v[rr][4 * i + 3] *= g4.w; }
        }
    }
#pragma unroll
    for (int rr = 0; rr < 2; ++rr) {
        float am = 0.f, ss = 0.f;
#pragma unroll
        for (int i = 0; i < 16; ++i) { am = fmaxf(am, fabsf(v[rr][i])); ss += v[rr][i] * v[rr][i]; }
        ss = wave_sum(ss);
        am = wave_max(am);
        float s = fmaxf(2.5f * sqrtf(ss * (1.f / D_)), am * (1.f / 16.f)) * (1.f / 7.f);
        if (!(s > 0.f)) s = 1.f;
        const float inv = 1.f / s;
        if (lane == 0) step[(row0 + rr) * 2] = s;
        unsigned w[2];
#pragma unroll
        for (int d = 0; d < 2; ++d) {
            unsigned acc = 0u;
#pragma unroll
            for (int e = 0; e < 8; ++e) {
                const int q = (int)fminf(fmaxf(rintf(v[rr][8 * d + e] * inv), -8.f), 7.f);
                if (UENC) acc |= (unsigned)(q & 15) << (4 * e);
                else acc |= (unsigned)((e < 4) ? (q + 8) : (q & 15)) << ((e & 3) * 8 + (e >> 2) * 4);
            }
            w[d] = acc;
        }
        *(uint2*)(dst + (size_t)(row0 + rr) * 1024 + lane * 16) = make_uint2(w[0], w[1]);
    }
}
__device__ __forceinline__ float ub0(unsigned w) { float r; asm("v_cvt_f32_ubyte0 %0, %1" : "=v"(r) : "v"(w)); return r; }
__device__ __forceinline__ float ub1(unsigned w) { float r; asm("v_cvt_f32_ubyte1 %0, %1" : "=v"(r) : "v"(w)); return r; }
__device__ __forceinline__ float ub2(unsigned w) { float r; asm("v_cvt_f32_ubyte2 %0, %1" : "=v"(r) : "v"(w)); return r; }
__device__ __forceinline__ float ub3(unsigned w) { float r; asm("v_cvt_f32_ubyte3 %0, %1" : "=v"(r) : "v"(w)); return r; }
template <int CTRL> __device__ __forceinline__ int dpp_i(int x) { return __builtin_amdgcn_update_dpp(0, x, CTRL, 0xF, 0xF, true); }
__device__ __forceinline__ int transpose_reduce16(const int (&pd)[16], const int sel) {
    int q8[8], q4[4];
#pragma unroll
    for (int i = 0; i < 8; ++i) { auto rr = __builtin_amdgcn_permlane32_swap((unsigned)pd[i], (unsigned)pd[i + 8], false, false); q8[i] = (int)rr[0] + (int)rr[1]; }
#pragma unroll
    for (int i = 0; i < 4; ++i) {
        auto rr = __builtin_amdgcn_permlane16_swap((unsigned)q8[i], (unsigned)q8[i + 4], false, false);
        int x = (int)rr[0] + (int)rr[1];
        x += dpp_i<0xB1>(x); x += dpp_i<0x4E>(x); x += dpp_i<0x124>(x); x += dpp_i<0x128>(x);
        q4[i] = x;
    }
    return sel == 0 ? q4[0] : sel == 1 ? q4[1] : sel == 2 ? q4[2] : q4[3];
}
template <bool FUSE_NORM>
__device__ __forceinline__ void d_peer_expert5(const int vb, const bfu* __restrict__ xin, bfu* xn, const int* idx, const float* gate,
                                               const unsigned char* __restrict__ ut, const unsigned char* __restrict__ vt, const float* __restrict__ usc, const float* __restrict__ vsc, float* x,
                                               const float* __restrict__ g1n, const float* swg, const float* __restrict__ ib, const float* __restrict__ fb, float* __restrict__ gi, float* __restrict__ glf) {
    const int tid = otid(), lane = tid & 63;
    const int wv = __builtin_amdgcn_readfirstlane(tid >> 6);
    const int t = vb * 4 + wv;
    int xh[2], xl[2]; float xs, rms;
    {
        float xv[16];
        const u32x4* xr = (const u32x4*)(xin + act_off(t, lane * 16));
        const u32x4 a = xr[0], b = xr[1];
#pragma unroll
        for (int q = 0; q < 4; ++q) { xv[2 * q] = bflo(a[q]); xv[2 * q + 1] = bfhi(a[q]); xv[8 + 2 * q] = bflo(b[q]); xv[8 + 2 * q + 1] = bfhi(b[q]); }
        float am = 0.f, sq = 0.f;
#pragma unroll
        for (int i = 0; i < 16; ++i) { am = fmaxf(am, fabsf(xv[i])); sq += xv[i] * xv[i]; }
        am = wave_max(am);
        rms = rsqrtf(wave_sum(sq) * (1.f / D_) + EPS);
        xs = am > 0.f ? am * (1.f / 119.f) : 1.f;
        const float inv = 1.f / xs;
#pragma unroll
        for (int d = 0; d < 2; ++d) {
            unsigned ah = 0u, al = 0u;
#pragma unroll
            for (int e = 0; e < 8; ++e) {
                const int q = (int)rintf(xv[8 * d + e] * inv);
                const int lo4 = ((q + 8) & 15) - 8, hi4 = (q - lo4) >> 4;
                ah |= (unsigned)(hi4 & 15) << (4 * e); al |= (unsigned)(lo4 & 15) << (4 * e);
            }
            xh[d] = (int)ah; xl[d] = (int)al;
        }
    }
    float y[16];
#pragma unroll
    for (int i = 0; i < 16; ++i) y[i] = 0.f;
    const int* ip = idx + (size_t)t * 128; const float* gp = gate + (size_t)t * 128;
    const int sel = (lane >> 2) & 3;
    const int el = ((lane >> 5) & 1) * 8 + ((lane >> 4) & 1) * 4 + sel;
#pragma unroll 1
    for (int e0 = 0; e0 < 128; e0 += 32) {
        uint2 u[32], v[32];
#pragma unroll
        for (int j = 0; j < 32; ++j) {
            const int id = ip[e0 + j];
            const u32x4 uv = *(const u32x4*)(ut + (size_t)id * 1024 + lane * 16);
            u[j] = make_uint2(uv[0], uv[1]); v[j] = make_uint2(uv[2], uv[3]);
        }
        const int myid0 = ip[e0 + el], myid1 = ip[e0 + 16 + el];
        const float ge0 = __expf(rms * gp[e0 + el]), ge1 = __expf(rms * gp[e0 + 16 + el]);
        float gt0 = ge0, gt1 = ge1;
        gt0 += dpp_f<0x128>(gt0); gt1 += dpp_f<0x128>(gt1); gt0 += dpp_f<0x124>(gt0); gt1 += dpp_f<0x124>(gt1);
        { auto r0 = __builtin_amdgcn_permlane16_swap(__float_as_uint(gt0), __float_as_uint(gt0), false, false); gt0 = __uint_as_float(r0[0]) + __uint_as_float(r0[1]);
          auto r1 = __builtin_amdgcn_permlane16_swap(__float_as_uint(gt1), __float_as_uint(gt1), false, false); gt1 = __uint_as_float(r1[0]) + __uint_as_float(r1[1]); }
        { auto r0 = __builtin_amdgcn_permlane32_swap(__float_as_uint(gt0), __float_as_uint(gt0), false, false); gt0 = __uint_as_float(r0[0]) + __uint_as_float(r0[1]);
          auto r1 = __builtin_amdgcn_permlane32_swap(__float_as_uint(gt1), __float_as_uint(gt1), false, false); gt1 = __uint_as_float(r1[0]) + __uint_as_float(r1[1]); }
        const float2 sc0 = *(const float2*)(usc + 2 * myid0), sc1 = *(const float2*)(usc + 2 * myid1);
        const float us0 = sc0.x * (xs * rms), us1 = sc1.x * (xs * rms), gs0 = ge0 / gt0 * sc0.y, gs1 = ge1 / gt1 * sc1.y;
        float w0, w1;
        {
            int pd[16];
#pragma unroll
            for (int j = 0; j < 16; ++j) {
                int acch = __builtin_amdgcn_sdot8((int)u[j].x, xh[0], 0, false);
                acch = __builtin_amdgcn_sdot8((int)u[j].y, xh[1], acch, false);
                int accl = __builtin_amdgcn_sdot8((int)u[j].x, xl[0], 0, false);
                accl = __builtin_amdgcn_sdot8((int)u[j].y, xl[1], accl, false);
                pd[j] = (acch << 4) + accl;
            }
            w0 = gelu_tanh((float)transpose_reduce16(pd, sel) * us0) * gs0;
#pragma unroll
            for (int j = 0; j < 16; ++j) {
                int acch = __builtin_amdgcn_sdot8((int)u[16 + j].x, xh[0], 0, false);
                acch = __builtin_amdgcn_sdot8((int)u[16 + j].y, xh[1], acch, false);
                int accl = __builtin_amdgcn_sdot8((int)u[16 + j].x, xl[0], 0, false);
                accl = __builtin_amdgcn_sdot8((int)u[16 + j].y, xl[1], accl, false);
                pd[j] = (acch << 4) + accl;
            }
            w1 = gelu_tanh((float)transpose_reduce16(pd, sel) * us1) * gs1;
        }
        float wam = fmaxf(fabsf(w0), fabsf(w1));
        wam = wave_max(wam);
        const float wsc = wam > 0.f ? wam * (1.f / 127.f) : 1.f, winv = 1.f / wsc;
        const int wq0 = (int)rintf(w0 * winv), wq1 = (int)rintf(w1 * winv);
        unsigned wpk[8]; int swq = 0;
#pragma unroll
        for (int g = 0; g < 8; ++g) {
            int bq[4];
#pragma unroll
            for (int i = 0; i < 4; ++i) {
                const int j = 4 * g + i, jj = j & 15;
                bq[i] = __builtin_amdgcn_readlane(j < 16 ? wq0 : wq1, ((jj >> 3) & 1) * 32 + ((jj >> 2) & 1) * 16 + (jj & 3) * 4);
                swq += bq[i];
            }
            wpk[g] = (unsigned)(bq[0] & 255) | ((unsigned)(bq[1] & 255) << 8) | ((unsigned)(bq[2] & 255) << 16) | ((unsigned)bq[3] << 24);
        }
        int a1[8], a2[8];
#pragma unroll
        for (int e = 0; e < 8; ++e) { a1[e] = -8 * swq; a2[e] = 0; }
#pragma unroll
        for (int g = 0; g < 8; ++g) {
#pragma unroll
            for (int s = 0; s < 2; ++s) {
                unsigned q[4];
#pragma unroll
                for (int i = 0; i < 4; ++i) q[i] = s ? v[4 * g + i].y : v[4 * g + i].x;
                const unsigned p0 = __builtin_amdgcn_perm(q[1], q[0], 0x05010400u), p1 = __builtin_amdgcn_perm(q[1], q[0], 0x07030602u);
                const unsigned p2 = __builtin_amdgcn_perm(q[3], q[2], 0x05010400u), p3 = __builtin_amdgcn_perm(q[3], q[2], 0x07030602u);
                const unsigned t0 = __builtin_amdgcn_perm(p2, p0, 0x05040100u), t1 = __builtin_amdgcn_perm(p2, p0, 0x07060302u);
                const unsigned t2 = __builtin_amdgcn_perm(p3, p1, 0x05040100u), t3 = __builtin_amdgcn_perm(p3, p1, 0x07060302u);
                a1[4 * s] = __builtin_amdgcn_sdot4((int)t0, (int)wpk[g], a1[4 * s], false);
                a1[4 * s + 1] = __builtin_amdgcn_sdot4((int)t1, (int)wpk[g], a1[4 * s + 1], false);
                a1[4 * s + 2] = __builtin_amdgcn_sdot4((int)t2, (int)wpk[g], a1[4 * s + 2], false);
                a1[4 * s + 3] = __builtin_amdgcn_sdot4((int)t3, (int)wpk[g], a1[4 * s + 3], false);
                a2[4 * s] = __builtin_amdgcn_sdot4((int)(t0 & 0xF0F0F0F0u), (int)wpk[g], a2[4 * s], false);
                a2[4 * s + 1] = __builtin_amdgcn_sdot4((int)(t1 & 0xF0F0F0F0u), (int)wpk[g], a2[4 * s + 1], false);
                a2[4 * s + 2] = __builtin_amdgcn_sdot4((int)(t2 & 0xF0F0F0F0u), (int)wpk[g], a2[4 * s + 2], false);
                a2[4 * s + 3] = __builtin_amdgcn_sdot4((int)(t3 & 0xF0F0F0F0u), (int)wpk[g], a2[4 * s + 3], false);
            }
        }
        int yi[16];
#pragma unroll
        for (int s = 0; s < 2; ++s)
#pragma unroll
            for (int e = 0; e < 4; ++e) { yi[8 * s + e] = a1[4 * s + e] - a2[4 * s + e]; yi[8 * s + e + 4] = a2[4 * s + e] >> 4; }
#pragma unroll
        for (int e = 0; e < 16; ++e) y[e] += wsc * (float)yi[e];
    }
    float4* xo = (float4*)(x + (size_t)t * D_ + lane * 16);
    float ss = 0.f;
#pragma unroll
    for (int i = 0; i < 4; ++i) {
        float4 r0 = xo[i]; r0.x += y[4 * i]; r0.y += y[4 * i + 1]; r0.z += y[4 * i + 2]; r0.w += y[4 * i + 3]; xo[i] = r0;
        y[4 * i] = r0.x; y[4 * i + 1] = r0.y; y[4 * i + 2] = r0.z; y[4 * i + 3] = r0.w;
        ss += r0.x * r0.x + r0.y * r0.y + r0.z * r0.z + r0.w * r0.w;
    }
    if (FUSE_NORM) {
        ss = wave_sum(ss);
        const float rn = rsqrtf(ss * (1.f / D_) + EPS);
#pragma unroll
        for (int i = 0; i < 4; ++i) { const float4 gg = *(const float4*)(g1n + lane * 16 + 4 * i); y[4 * i] *= rn * gg.x; y[4 * i + 1] *= rn * gg.y; y[4 * i + 2] *= rn * gg.z; y[4 * i + 3] *= rn * gg.w; }
        u32x4 o0, o1;
#pragma unroll
        for (int i = 0; i < 4; ++i) { o0[i] = pk2(y[2 * i], y[2 * i + 1]); o1[i] = pk2(y[8 + 2 * i], y[8 + 2 * i + 1]); }
        u32x4* xw = (u32x4*)(xn + act_off(t, lane * 16));
        xw[0] = o0; xw[1] = o1;
        float mine = 0.f;
#pragma unroll
        for (int j = 0; j < 12; ++j) {
            float part = 0.f;
#pragma unroll
            for (int i = 0; i < 4; ++i) { const float4 w4 = *(const float4*)(swg + j * 1024 + lane * 16 + 4 * i); part += y[4 * i] * w4.x + y[4 * i + 1] * w4.y + y[4 * i + 2] * w4.z + y[4 * i + 3] * w4.w; }
            part = wave_sum(part);
            if (lane == j) mine = part;
        }
        const int b = t / S_, s = t % S_;
        if (lane < 6) gi[((size_t)b * 6 + lane) * S_ + s] = mine + ib[lane];
        else if (lane < 12) glf[((size_t)b * 6 + lane - 6) * S_ + s] = logsigmoid_f(mine + fb[lane - 6]);
    }
}

__device__ __forceinline__ void store_pairs16(bfu* rowbase, const uint2 (&c)[4], const int h) {
#pragma unroll
    for (int g = 0; g < 4; g += 2) {
        const auto rx = __builtin_amdgcn_permlane32_swap(c[g].x, c[g + 1].x, false, false), ry = __builtin_amdgcn_permlane32_swap(c[g].y, c[g + 1].y, false, false);
        u32x4 o; o[0] = rx[0]; o[1] = ry[0]; o[2] = rx[1]; o[3] = ry[1];
        *(u32x4*)(rowbase + 8 * (g + h)) = o;
    }
}
typedef short v4i16_t __attribute__((ext_vector_type(4)));
__device__ __forceinline__ s16x4 vtr(const char* p) { return __builtin_bit_cast(s16x4, __builtin_amdgcn_ds_read_tr16_b64_v4i16((LAS v4i16_t*)p)); }
__device__ __forceinline__ void sb_subtile(const f32x16& p, const int keybase, const int qg, const bool diag, const int h, float& carry, bf16x8& f0, bf16x8& f1) {
    float bt[16], rr[16];
#pragma unroll
    for (int e = 0; e < 16; ++e) {
        float pe = fminf(p[e], 120.f);
        if (diag) { const int key = keybase + (e & 3) + 8 * (e >> 2); if (key >= qg) pe = -INFINITY; }
        const float t = __builtin_amdgcn_exp2f(pe);
        const float r = __builtin_amdgcn_rcpf(1.f + t);
        bt[e] = t * r; rr[e] = r;
    }
    float lo[4], hi[4];
#pragma unroll
    for (int g = 0; g < 4; ++g) swap32((rr[4 * g] * rr[4 * g + 1]) * (rr[4 * g + 2] * rr[4 * g + 3]), lo[g], hi[g]);
    float T[8];
    T[7] = 1.f; T[6] = hi[3]; T[5] = T[6] * lo[3]; T[4] = T[5] * hi[2]; T[3] = T[4] * lo[2]; T[2] = T[3] * hi[1]; T[1] = T[2] * lo[1]; T[0] = T[1] * hi[0];
    const float total = T[0] * lo[0];
    float w[16];
#pragma unroll
    for (int g = 0; g < 4; ++g) {
        float c = carry * (h ? T[2 * g + 1] : T[2 * g]);
#pragma unroll
        for (int i = 3; i >= 0; --i) {
            const int e = 4 * g + i;
            w[e] = bt[e] * c;
            c *= rr[e];
        }
    }
    carry *= total;
    u32x4 a, b;
#pragma unroll
    for (int i = 0; i < 4; ++i) { a[i] = pk2(w[2 * i], w[2 * i + 1]); b[i] = pk2(w[8 + 2 * i], w[8 + 2 * i + 1]); }
    f0 = __builtin_bit_cast(bf16x8, a); f1 = __builtin_bit_cast(bf16x8, b);
}
constexpr int SBA_LDS = 32768;
__device__ __forceinline__ void d_sb_attn2(const int unit, const bfu* __restrict__ Qs, const bfu* __restrict__ Ks, const bfu* __restrict__ Vs,
                                           const float* __restrict__ og, bfu* __restrict__ y, char* lds) {
    const int qb = 31 - unit / 48, bh = unit % 48, b = bh / 6, hh = bh % 6;
    const int tid = otid(), lane = tid & 63, r = lane & 31, h = lane >> 5;
    const int wid = __builtin_amdgcn_readfirstlane(tid >> 6);
    const bfu* Kg = Ks + (size_t)bh * S_ * 64; const bfu* Vg = Vs + (size_t)bh * S_ * 64;
    const int q0 = qb * 128 + wid * 32, qg = q0 + r;
    bf16x8 qf[4];
#pragma unroll
    for (int ks = 0; ks < 4; ++ks) qf[ks] = *(const bf16x8*)(Qs + (size_t)bh * S_ * 64 + ((size_t)(2 * ks + h) * S_ + qg) * 8);
    f32x16 o0, o1;
#pragma unroll
    for (int e = 0; e < 16; ++e) { o0[e] = 0.f; o1[e] = 0.f; }
    float carry = 1.f;
    const int nt = 2 * qb + 2;
    const int srow = tid >> 3, sch = tid & 7;
    const int koff = srow * 128 + ((sch ^ (srow & 7)) << 4), voff = 8192 + (sch >> 2) * 4096 + srow * 64 + (sch & 3) * 16;
    u32x4 sk0, sk1, sv0, sv1;
#define GLOAD(kt) { const size_t gb = ((size_t)sch * S_ + (kt) * 64 + srow) * 8; sk0 = *(const u32x4*)(Kg + gb); sk1 = *(const u32x4*)(Kg + gb + 256); sv0 = *(const u32x4*)(Vg + gb); sv1 = *(const u32x4*)(Vg + gb + 256); }
#define LSTORE(buf) { char* bb = lds + (buf) * 16384; *(u32x4*)(bb + koff) = sk0; *(u32x4*)(bb + koff + 4096) = sk1; *(u32x4*)(bb + voff) = sv0; *(u32x4*)(bb + voff + 2048) = sv1; }
    __syncthreads();
    GLOAD(nt - 1); LSTORE(0);
    __syncthreads();
    const int kro = r * 128, sw = r & 7;
    volatile int* sflag = (volatile int*)(lds + SBA_LDS);
    const int vlane = 8192 + ((lane >> 4) & 1) * 32 + (lane & 3) * 8 + (4 * h + ((lane & 15) >> 2)) * 64;
#pragma unroll 1
    for (int it = 0; it < nt; ++it) {
        const int kt = nt - 1 - it;
        if (it + 1 < nt) GLOAD(kt - 1);
        const char* kb_ = lds + (it & 1) * 16384;
        f32x16 p0, p1;
#pragma unroll
        for (int e = 0; e < 16; ++e) { p0[e] = 0.f; p1[e] = 0.f; }
#pragma unroll
        for (int ks = 0; ks < 4; ++ks) {
            const int co = ((2 * ks + h) ^ sw) << 4;
            const bf16x8 k0 = *(const bf16x8*)(kb_ + kro + co), k1 = *(const bf16x8*)(kb_ + kro + 4096 + co);
            p0 = MFMA32(k0, qf[ks], p0); p1 = MFMA32(k1, qf[ks], p1);
        }
        const bool diag = kt >= 2 * qb;
        bf16x8 pf[4];
        sb_subtile(p1, kt * 64 + 32 + 4 * h, qg, diag, h, carry, pf[2], pf[3]);
        sb_subtile(p0, kt * 64 + 4 * h, qg, diag, h, carry, pf[0], pf[1]);
#pragma unroll
        for (int kk = 0; kk < 4; ++kk) {
            const char* vp = kb_ + vlane + kk * 1024;
            const s16x4 a0 = vtr(vp), a1 = vtr(vp + 512), b0 = vtr(vp + 4096), b1 = vtr(vp + 4096 + 512);
            const bf16x8 v0 = __builtin_shufflevector(a0, a1, 0, 1, 2, 3, 4, 5, 6, 7), v1 = __builtin_shufflevector(b0, b1, 0, 1, 2, 3, 4, 5, 6, 7);
            o0 = MFMA32(v0, pf[kk], o0); o1 = MFMA32(v1, pf[kk], o1);
        }
        if (it + 1 < nt) LSTORE((it + 1) & 1);
        const int alldone = __all(carry < 0x1p-120f) ? 1 : 0;
        if (lane == 0) sflag[(it & 1) * 4 + wid] = alldone;
        __syncthreads();
        if ((sflag[(it & 1) * 4] & sflag[(it & 1) * 4 + 1] & sflag[(it & 1) * 4 + 2] & sflag[(it & 1) * 4 + 3]) != 0) break;
    }
#undef GLOAD
#undef LSTORE
    float ss = 0.f;
#pragma unroll
    for (int e = 0; e < 16; ++e) ss += o0[e] * o0[e] + o1[e] * o1[e];
    float slo, shi; swap32(ss, slo, shi);
    const float rinv = rsqrtf((slo + shi) * (1.f / 64) + EPS);
    bfu* yp = y + act_off((size_t)b * S_ + qg, hh * 64);
    const float* gp = og + hh * 64 + 4 * h;
    uint2 c0[4], c1[4];
#pragma unroll
    for (int g = 0; g < 4; ++g) {
        const float4 g0 = *(const float4*)(gp + 8 * g), g1 = *(const float4*)(gp + 32 + 8 * g);
        c0[g] = make_uint2(pk2(o0[4 * g] * rinv * g0.x, o0[4 * g + 1] * rinv * g0.y), pk2(o0[4 * g + 2] * rinv * g0.z, o0[4 * g + 3] * rinv * g0.w));
        c1[g] = make_uint2(pk2(o1[4 * g] * rinv * g1.x, o1[4 * g + 1] * rinv * g1.y), pk2(o1[4 * g + 2] * rinv * g1.z, o1[4 * g + 3] * rinv * g1.w));
    }
    store_pairs16(yp, c0, h); store_pairs16(yp + (size_t)T_ * 32, c1, h);
}

__device__ __forceinline__ void d_cvt_sgw(const int vb, const float* __restrict__ src, bfu* __restrict__ dst) {
    const size_t e = (size_t)vb * 2048 + otid() * 8;
    const int s0 = (int)(e & 127), t = (int)((e >> 7) & 127);
    const float4 a = *(const float4*)(src + e), b = *(const float4*)(src + e + 4);
    const float v[8] = {a.x, a.y, a.z, a.w, b.x, b.y, b.z, b.w};
    u32x4 o;
#pragma unroll
    for (int i = 0; i < 4; ++i) o[i] = pk2(s0 + 2 * i <= t ? v[2 * i] : 0.f, s0 + 2 * i + 1 <= t ? v[2 * i + 1] : 0.f);
    *(u32x4*)(dst + e) = o;
}

__device__ __forceinline__ float silu_f(float x) { return x * __builtin_amdgcn_rcpf(1.f + __expf(-x)); }
__device__ __forceinline__ void ml_scan(const float* __restrict__ gi, const float* __restrict__ glf, const int lane, float* s_b, float* s_a, float* s_A, float& b_last, float& A_last) {
    const float2 f = *(const float2*)(glf + 2 * lane), iv = *(const float2*)(gi + 2 * lane);
    float x = f.x + f.y;
#pragma unroll
    for (int o = 1; o < 64; o <<= 1) { const float t = __shfl_up(x, o, 64); if (lane >= o) x += t; }
    const float b1 = x, b0 = x - f.y;
    const float a0 = iv.x - b0, a1 = iv.y - b1;
    float m = fmaxf(a0, a1);
#pragma unroll
    for (int o = 1; o < 64; o <<= 1) { const float t = __shfl_up(m, o, 64); if (lane >= o) m = fmaxf(m, t); }
    float prev = __shfl_up(m, 1, 64); if (lane == 0) prev = -INFINITY;
    *(float2*)(s_b + 2 * lane) = make_float2(b0, b1);
    *(float2*)(s_a + 2 * lane) = make_float2(a0, a1);
    *(float2*)(s_A + 2 * lane) = make_float2(fmaxf(prev, a0), m);
    b_last = __shfl(b1, 63, 64); A_last = __shfl(m, 63, 64);
}
__device__ __forceinline__ void conv8(const bfu* __restrict__ raw, const int sg, const int ch, const float* __restrict__ cw, const float* __restrict__ cb, float (&out)[8]) {
    const float4 b0 = *(const float4*)(cb + ch * 8), b1 = *(const float4*)(cb + ch * 8 + 4);
    out[0] = b0.x; out[1] = b0.y; out[2] = b0.z; out[3] = b0.w; out[4] = b1.x; out[5] = b1.y; out[6] = b1.z; out[7] = b1.w;
#pragma unroll
    for (int j = 0; j < 4; ++j) {
        const int sp = sg - 3 + j;
        u32x4 v = {0u, 0u, 0u, 0u};
        if (sp >= 0) v = *(const u32x4*)(raw + ((size_t)ch * S_ + sp) * 8);
        const float4 w0 = *(const float4*)(cw + j * 768 + ch * 8), w1 = *(const float4*)(cw + j * 768 + ch * 8 + 4);
        out[0] += bflo(v[0]) * w0.x; out[1] += bfhi(v[0]) * w0.y; out[2] += bflo(v[1]) * w0.z; out[3] += bfhi(v[1]) * w0.w;
        out[4] += bflo(v[2]) * w1.x; out[5] += bfhi(v[2]) * w1.y; out[6] += bflo(v[3]) * w1.z; out[7] += bfhi(v[3]) * w1.w;
    }
#pragma unroll
    for (int i = 0; i < 8; ++i) out[i] = silu_f(out[i]);
}
__device__ __forceinline__ u32x4 pack8(const float (&v)[8], const float sc) {
    u32x4 o; o[0] = pk2(v[0] * sc, v[1] * sc); o[1] = pk2(v[2] * sc, v[3] * sc); o[2] = pk2(v[4] * sc, v[5] * sc); o[3] = pk2(v[6] * sc, v[7] * sc); return o;
}
__device__ __forceinline__ bf16x8 trfrag(const char* p, const int second) {
    const s16x4 a = vtr(p), b = vtr(p + second);
    return __builtin_shufflevector(a, b, 0, 1, 2, 3, 4, 5, 6, 7);
}
constexpr int MLA_LDS = 2048 + 32768 + 1024;
__device__ __forceinline__ void d_ml_a(const int unit, const bfu* __restrict__ mkr, const bfu* __restrict__ mvr, const float* __restrict__ gi, const float* __restrict__ glf,
                                       const float* __restrict__ cw, const float* __restrict__ cb, float* __restrict__ Wloc, float* __restrict__ nloc, float* __restrict__ scal, char* lds) {
    const int bh = unit >> 5, c = unit & 31, hh = bh % 6;
    const int tid = otid(), lane = tid & 63, r = lane & 31, h = lane >> 5;
    const int wid = __builtin_amdgcn_readfirstlane(tid >> 6);
    float* s_ws = (float*)lds; float* s_a = s_ws + 128; float* s_b = s_a + 128; float* s_A = s_b + 128;
    char* KW = lds + 2048; char* VI = KW + 16384; float* s_ns = (float*)(VI + 16384);
    __syncthreads();
    if (wid == 0) {
        float bl, al;
        ml_scan(gi + (size_t)bh * S_ + c * 128, glf + (size_t)bh * S_ + c * 128, lane, s_b, s_a, s_A, bl, al);
        const float2 a2 = *(const float2*)(s_a + 2 * lane);
        *(float2*)(s_ws + 2 * lane) = make_float2(__expf(a2.x - al), __expf(a2.y - al));
        if (lane == 0) { scal[(size_t)unit * 2] = bl; scal[(size_t)unit * 2 + 1] = al; }
    }
    __syncthreads();
    const bfu* kraw = mkr + (size_t)bh * S_ * 64; const bfu* vraw = mvr + (size_t)bh * S_ * 64;
#pragma unroll 1
    for (int it = 0; it < 4; ++it) {
        const int item = tid + 256 * it, s = item >> 3, ch = item & 7;
        float kv[8]; conv8(kraw, c * 128 + s, ch, cw + 384 + hh * 64, cb + 384 + hh * 64, kv);
        const int off = (ch >> 2) * 8192 + s * 64 + (ch & 3) * 16;
        *(u32x4*)(KW + off) = pack8(kv, 0.125f * s_ws[s]);
        *(u32x4*)(VI + off) = *(const u32x4*)(vraw + ((size_t)ch * S_ + c * 128 + s) * 8);
    }
    __syncthreads();
    {
        const int dvt = wid >> 1, dkt = wid & 1;
        const int trn = ((lane >> 4) & 1) * 32 + (lane & 3) * 8 + (8 * h + ((lane & 15) >> 2)) * 64;
        f32x16 acc;
#pragma unroll
        for (int e = 0; e < 16; ++e) acc[e] = 0.f;
#pragma unroll
        for (int ks = 0; ks < 8; ++ks) {
            const bf16x8 af = trfrag(VI + dvt * 8192 + trn + ks * 1024, 256), bf = trfrag(KW + dkt * 8192 + trn + ks * 1024, 256);
            acc = MFMA32(af, bf, acc);
        }
        float* wp = Wloc + (size_t)unit * 4096 + (size_t)(32 * dvt) * 64 + 32 * dkt + r;
#pragma unroll
        for (int e = 0; e < 16; ++e) wp[crow(e, h) * 64] = acc[e];
        const int dk = tid & 63, part = tid >> 6;
        float ns = 0.f;
        const char* kp = KW + (dk >> 5) * 8192 + (dk & 31) * 2 + part * 32 * 64;
#pragma unroll 8
        for (int s = 0; s < 32; ++s) ns += bf2f(*(const bfu*)(kp + s * 64));
        s_ns[part * 64 + dk] = ns;
    }
    __syncthreads();
    if (tid < 64) nloc[(size_t)unit * 64 + tid] = (s_ns[tid] + s_ns[64 + tid]) + (s_ns[128 + tid] + s_ns[192 + tid]);
}
constexpr int MLB_LDS = 2304 + 3 * 16384 + 8192;
__device__ __forceinline__ void d_ml_b(const int unit, const bfu* __restrict__ mqr, const bfu* __restrict__ mkr, const bfu* __restrict__ mvr, const bfu* __restrict__ mo,
                                       const float* __restrict__ gi, const float* __restrict__ glf, const float* __restrict__ cw, const float* __restrict__ cb,
                                       const float* __restrict__ Wloc, const float* __restrict__ nloc, const float* __restrict__ scal,
                                       const float* __restrict__ og, bfu* __restrict__ y, char* lds) {
    const int c = 31 - unit / 48, bh = unit % 48, b = bh / 6, hh = bh % 6;
    const int tid = otid(), lane = tid & 63, r = lane & 31, h = lane >> 5;
    const int wid = __builtin_amdgcn_readfirstlane(tid >> 6);
    float* s_b = (float*)lds; float* s_a = s_b + 128; float* s_A = s_a + 128; float* s_n = s_A + 128; float* s_coef = s_n + 64;
    float* s_dlog = s_coef + 32; float* s_alog = s_dlog + 32; float* s_mp = s_alog + 32;
    char* QI = lds + 2304; char* KI = QI + 16384; char* VI = KI + 16384; char* CI = VI + 16384;
    __syncthreads();
    if (wid == 0) { float bl, al; ml_scan(gi + (size_t)bh * S_ + c * 128, glf + (size_t)bh * S_ + c * 128, lane, s_b, s_a, s_A, bl, al); }
    else if (wid == 1) {
        float blv = 0.f, alv = 0.f;
        if (lane < c) { blv = scal[((size_t)bh * 32 + lane) * 2]; alv = scal[((size_t)bh * 32 + lane) * 2 + 1]; }
        float m = 0.f, mydl = 0.f, myal = 0.f;
        for (int j = 0; j < c; ++j) {
            const float bl = __shfl(blv, j, 64), al = __shfl(alv, j, 64);
            const float M = fmaxf(m, al);
            if (lane == j) { mydl = m - M; myal = al - M; }
            m = bl + M;
        }
        if (lane < 32) { s_dlog[lane] = mydl; s_alog[lane] = myal; }
        if (lane == 0) s_mp[0] = m;
    }
    {
        const bfu* qraw = mqr + (size_t)bh * S_ * 64; const bfu* kraw = mkr + (size_t)bh * S_ * 64; const bfu* vraw = mvr + (size_t)bh * S_ * 64;
#pragma unroll 1
        for (int it = 0; it < 4; ++it) {
            const int item = tid + 256 * it, s = item >> 3, ch = item & 7;
            float v8[8];
            conv8(qraw, c * 128 + s, ch, cw + hh * 64, cb + hh * 64, v8);
            const int ro = s * 128 + ((ch ^ (s & 7)) << 4);
            *(u32x4*)(QI + ro) = pack8(v8, 1.f);
            conv8(kraw, c * 128 + s, ch, cw + 384 + hh * 64, cb + 384 + hh * 64, v8);
            *(u32x4*)(KI + ro) = pack8(v8, 0.125f);
            *(u32x4*)(VI + (ch >> 2) * 8192 + s * 64 + (ch & 3) * 16) = *(const u32x4*)(vraw + ((size_t)ch * S_ + c * 128 + s) * 8);
        }
    }
    __syncthreads();
    if (tid < 32) {
        float L = s_alog[tid];
        for (int j = tid + 1; j < c; ++j) L += s_dlog[j];
        s_coef[tid] = (tid < c) ? __expf(L) : 0.f;
    }
    __syncthreads();
    {
        float4 acc[4];
#pragma unroll
        for (int i = 0; i < 4; ++i) acc[i] = make_float4(0.f, 0.f, 0.f, 0.f);
        float nacc = 0.f;
        const float* wb = Wloc + (size_t)bh * 32 * 4096 + tid * 4;
#pragma unroll 2
        for (int j = 0; j < c; ++j) {
            const float cf = s_coef[j];
#pragma unroll
            for (int i = 0; i < 4; ++i) { const float4 w = *(const float4*)(wb + (size_t)j * 4096 + 1024 * i); acc[i].x += cf * w.x; acc[i].y += cf * w.y; acc[i].z += cf * w.z; acc[i].w += cf * w.w; }
            if (tid < 64) nacc += cf * nloc[((size_t)bh * 32 + j) * 64 + tid];
        }
#pragma unroll
        for (int i = 0; i < 4; ++i) {
            const int e = tid * 4 + 1024 * i, dv = e >> 6, dk = e & 63;
            *(uint2*)(CI + dv * 128 + (((dk >> 3) ^ (dv & 7)) << 4) + (dk & 7) * 2) = make_uint2(pk2(acc[i].x, acc[i].y), pk2(acc[i].z, acc[i].w));
        }
        if (tid < 64) s_n[tid] = nacc;
    }
    __syncthreads();
    {
        const int t = 32 * wid + r, tg = c * 128 + t, sw = r & 7;
        const float m_prev = s_mp[0];
        bf16x8 qf[4];
#pragma unroll
        for (int ks = 0; ks < 4; ++ks) qf[ks] = *(const bf16x8*)(QI + t * 128 + (((2 * ks + h) ^ sw) << 4));
        const float Mt = fmaxf(m_prev, s_A[t]);
        const float isc = __expf(m_prev - Mt);
        f32x16 n0, n1;
#pragma unroll
        for (int e = 0; e < 16; ++e) { n0[e] = 0.f; n1[e] = 0.f; }
        float dsum = 0.f;
        const int trp = ((lane >> 4) & 1) * 32 + (lane & 3) * 8 + (4 * h + ((lane & 15) >> 2)) * 64;
#pragma unroll 1
        for (int u = 0; u <= wid; ++u) {
            f32x16 pacc;
#pragma unroll
            for (int e = 0; e < 16; ++e) pacc[e] = 0.f;
#pragma unroll
            for (int ks = 0; ks < 4; ++ks) {
                const bf16x8 kf = *(const bf16x8*)(KI + (32 * u + r) * 128 + (((2 * ks + h) ^ sw) << 4));
                pacc = MFMA32(kf, qf[ks], pacc);
            }
            float pw[16];
#pragma unroll
            for (int g = 0; g < 4; ++g) {
                const float4 a4 = *(const float4*)(s_a + 32 * u + 8 * g + 4 * h);
                const float av[4] = {a4.x, a4.y, a4.z, a4.w};
#pragma unroll
                for (int i = 0; i < 4; ++i) {
                    float val = pacc[4 * g + i] * __expf(av[i] - Mt);
                    if (u == wid && (8 * g + 4 * h + i) > r) val = 0.f;
                    dsum += val; pw[4 * g + i] = val;
                }
            }
            u32x4 pa, pb;
#pragma unroll
            for (int i = 0; i < 4; ++i) { pa[i] = pk2(pw[2 * i], pw[2 * i + 1]); pb[i] = pk2(pw[8 + 2 * i], pw[8 + 2 * i + 1]); }
            const bf16x8 pf0 = __builtin_bit_cast(bf16x8, pa), pf1 = __builtin_bit_cast(bf16x8, pb);
            const char* vp = VI + trp + (2 * u) * 1024;
            n0 = MFMA32(trfrag(vp, 512), pf0, n0); n1 = MFMA32(trfrag(vp + 8192, 512), pf0, n1);
            n0 = MFMA32(trfrag(vp + 1024, 512), pf1, n0); n1 = MFMA32(trfrag(vp + 8192 + 1024, 512), pf1, n1);
        }
        f32x16 i0, i1;
#pragma unroll
        for (int e = 0; e < 16; ++e) { i0[e] = 0.f; i1[e] = 0.f; }
        float qn = 0.f;
#pragma unroll
        for (int ks = 0; ks < 4; ++ks) {
            const int co = ((2 * ks + h) ^ sw) << 4;
            const bf16x8 c0 = *(const bf16x8*)(CI + r * 128 + co), c1 = *(const bf16x8*)(CI + (32 + r) * 128 + co);
            i0 = MFMA32(c0, qf[ks], i0); i1 = MFMA32(c1, qf[ks], i1);
            const u32x4 qu = __builtin_bit_cast(u32x4, qf[ks]);
            const float4 na = *(const float4*)(s_n + 16 * ks + 8 * h), nb = *(const float4*)(s_n + 16 * ks + 8 * h + 4);
            qn += bflo(qu[0]) * na.x + bfhi(qu[0]) * na.y + bflo(qu[1]) * na.z + bfhi(qu[1]) * na.w + bflo(qu[2]) * nb.x + bfhi(qu[2]) * nb.y + bflo(qu[3]) * nb.z + bfhi(qu[3]) * nb.w;
        }
        float lo, hi2; swap32(dsum, lo, hi2); const float dtot = lo + hi2;
        swap32(qn, lo, hi2); const float qtot = lo + hi2;
        const float den = dtot + isc * qtot;
        const float mt = s_b[t] + Mt;
        const float inv = 1.f / fmaxf(fabsf(den), __expf(-mt));
        float ss = 0.f;
#pragma unroll
        for (int e = 0; e < 16; ++e) { n0[e] = (n0[e] + isc * i0[e]) * inv; n1[e] = (n1[e] + isc * i1[e]) * inv; ss += n0[e] * n0[e] + n1[e] * n1[e]; }
        swap32(ss, lo, hi2);
        const float rinv = rsqrtf((lo + hi2) * (1.f / 64) + EPS);
        const size_t trow = (size_t)b * S_ + tg;
        bfu* yp = y + act_off(trow, 384 + hh * 64);
        uint2 c0[4], c1[4];
        const bfu* op = mo + ((size_t)hh * 8 * T_ + trow) * 8 + 4 * h;
        const float* gp = og + (6 + hh) * 64 + 4 * h;
#pragma unroll
        for (int g = 0; g < 4; ++g) {
            const float4 g0 = *(const float4*)(gp + 8 * g), g1 = *(const float4*)(gp + 32 + 8 * g);
            const uint2 o0 = *(const uint2*)(op + (size_t)g * T_ * 8), o1 = *(const uint2*)(op + (size_t)(4 + g) * T_ * 8);
            c0[g] = make_uint2(pk2(n0[4 * g] * rinv * g0.x * bflo(o0.x), n0[4 * g + 1] * rinv * g0.y * bfhi(o0.x)), pk2(n0[4 * g + 2] * rinv * g0.z * bflo(o0.y), n0[4 * g + 3] * rinv * g0.w * bfhi(o0.y)));
            c1[g] = make_uint2(pk2(n1[4 * g] * rinv * g1.x * bflo(o1.x), n1[4 * g + 1] * rinv * g1.y * bfhi(o1.x)), pk2(n1[4 * g + 2] * rinv * g1.z * bflo(o1.y), n1[4 * g + 3] * rinv * g1.w * bfhi(o1.y)));
        }
        store_pairs16(yp, c0, h); store_pairs16(yp + (size_t)T_ * 32, c1, h);
    }
}
constexpr int SG_LDS = 16384;
__device__ __forceinline__ void d_sg2(const int unit, const bfu* __restrict__ su, const bfu* __restrict__ svh, const bfu* __restrict__ wm, const float* __restrict__ bs,
                                      const float* __restrict__ og, bfu* __restrict__ y, char* lds) {
    const int g = unit & 3, c = (unit >> 2) & 31, b = unit >> 7;
    const int tid = otid(), lane = tid & 63, r = lane & 31, h = lane >> 5;
    const int wid = __builtin_amdgcn_readfirstlane(tid >> 6);
    char* VI = lds;
    __syncthreads();
    const bfu* vraw = svh + ((size_t)b * 4 + g) * S_ * 64 + (size_t)c * 128 * 8;
#pragma unroll
    for (int it = 0; it < 4; ++it) {
        const int item = tid + 256 * it, s = item >> 3, ch = item & 7;
        *(u32x4*)(VI + (ch >> 2) * 8192 + s * 64 + (ch & 3) * 16) = *(const u32x4*)(vraw + ((size_t)ch * S_ + s) * 8);
    }
    __syncthreads();
    const int t = 32 * wid + r;
    const int trn = ((lane >> 4) & 1) * 32 + (lane & 3) * 8 + (8 * h + ((lane & 15) >> 2)) * 64;
    f32x16 a0, a1;
#pragma unroll
    for (int e = 0; e < 16; ++e) { a0[e] = 0.f; a1[e] = 0.f; }
    const bfu* wr = wm + ((size_t)g * 128 + t) * 128 + 8 * h;
#pragma unroll 1
    for (int ks = 0; ks < 2 * wid + 2; ++ks) {
        const bf16x8 wf = *(const bf16x8*)(wr + 16 * ks);
        a0 = MFMA32(trfrag(VI + trn + ks * 1024, 256), wf, a0);
        a1 = MFMA32(trfrag(VI + 8192 + trn + ks * 1024, 256), wf, a1);
    }
    const float bias = bs[g * 128 + t];
    const size_t trow = (size_t)b * S_ + c * 128 + t;
    const bfu* up = su + ((size_t)g * 8 * T_ + trow) * 8 + 4 * h;
    float ss = 0.f;
#pragma unroll
    for (int q = 0; q < 4; ++q) {
        const uint2 u0 = *(const uint2*)(up + (size_t)q * T_ * 8), u1 = *(const uint2*)(up + (size_t)(4 + q) * T_ * 8);
        a0[4 * q] = (a0[4 * q] + bias) * bflo(u0.x); a0[4 * q + 1] = (a0[4 * q + 1] + bias) * bfhi(u0.x); a0[4 * q + 2] = (a0[4 * q + 2] + bias) * bflo(u0.y); a0[4 * q + 3] = (a0[4 * q + 3] + bias) * bfhi(u0.y);
        a1[4 * q] = (a1[4 * q] + bias) * bflo(u1.x); a1[4 * q + 1] = (a1[4 * q + 1] + bias) * bfhi(u1.x); a1[4 * q + 2] = (a1[4 * q + 2] + bias) * bflo(u1.y); a1[4 * q + 3] = (a1[4 * q + 3] + bias) * bfhi(u1.y);
    }
#pragma unroll
    for (int e = 0; e < 16; ++e) ss += a0[e] * a0[e] + a1[e] * a1[e];
    float lo, hi2; swap32(ss, lo, hi2);
    const float rinv = rsqrtf((lo + hi2) * (1.f / 64) + EPS);
    bfu* yp = y + act_off(trow, 768 + g * 64);
    uint2 c0[4], c1[4];
    const float* gp = og + (12 + g) * 64 + 4 * h;
#pragma unroll
    for (int q = 0; q < 4; ++q) {
        const float4 g0 = *(const float4*)(gp + 8 * q), g1 = *(const float4*)(gp + 32 + 8 * q);
        c0[q] = make_uint2(pk2(a0[4 * q] * rinv * g0.x, a0[4 * q + 1] * rinv * g0.y), pk2(a0[4 * q + 2] * rinv * g0.z, a0[4 * q + 3] * rinv * g0.w));
        c1[q] = make_uint2(pk2(a1[4 * q] * rinv * g1.x, a1[4 * q + 1] * rinv * g1.y), pk2(a1[4 * q + 2] * rinv * g1.z, a1[4 * q + 3] * rinv * g1.w));
    }
    store_pairs16(yp, c0, h); store_pairs16(yp + (size_t)T_ * 32, c1, h);
}

#define CE_D(a, b) { const float hi_ = fmaxf(a, b), lo_ = fminf(a, b); a = hi_; b = lo_; }
template <int B>
__device__ __forceinline__ void sort16_desc(float (&v)[64]) {
#define C2_(a, b) CE_D(v[B + a], v[B + b])
    C2_(0, 13) C2_(1, 12) C2_(2, 15) C2_(3, 14) C2_(4, 8) C2_(5, 6) C2_(7, 11) C2_(9, 10)
    C2_(0, 5) C2_(1, 7) C2_(2, 9) C2_(3, 4) C2_(6, 13) C2_(8, 14) C2_(10, 15) C2_(11, 12)
    C2_(0, 1) C2_(2, 3) C2_(4, 5) C2_(6, 8) C2_(7, 9) C2_(10, 11) C2_(12, 13) C2_(14, 15)
    C2_(0, 2) C2_(1, 3) C2_(4, 10) C2_(5, 11) C2_(6, 7) C2_(8, 9) C2_(12, 14) C2_(13, 15)
    C2_(1, 2) C2_(3, 12) C2_(4, 6) C2_(5, 7) C2_(8, 10) C2_(9, 11) C2_(13, 14)
    C2_(1, 4) C2_(2, 6) C2_(5, 8) C2_(7, 10) C2_(9, 13) C2_(11, 14)
    C2_(2, 4) C2_(3, 6) C2_(9, 12) C2_(11, 13)
    C2_(3, 5) C2_(6, 8) C2_(7, 9) C2_(10, 12)
    C2_(3, 4) C2_(5, 6) C2_(7, 8) C2_(9, 10) C2_(11, 12)
    C2_(6, 7) C2_(8, 9)
#undef C2_
}
template <int A0, int B0>
__device__ __forceinline__ void merge_top16(float (&v)[64]) {
#pragma unroll
    for (int i = 0; i < 16; ++i) v[A0 + i] = fmaxf(v[A0 + i], v[B0 + 15 - i]);
#pragma unroll
    for (int j = 8; j > 0; j >>= 1)
#pragma unroll
        for (int i = 0; i < 16; ++i) { const int l = i ^ j; if (l > i) { CE_D(v[A0 + i], v[A0 + l]); } }
}
__device__ __forceinline__ void top16_of_64(float (&v)[64]) {
    sort16_desc<0>(v); sort16_desc<16>(v); sort16_desc<32>(v); sort16_desc<48>(v);
    merge_top16<0, 16>(v); merge_top16<32, 48>(v); merge_top16<0, 32>(v);
}
__device__ __forceinline__ void d_compose_wq(const int unit, const float* __restrict__ wq_all, const float* __restrict__ keys_all, const float* __restrict__ g2_all, bfu* __restrict__ wt_all) {
    const int l = unit >> 7, hc = (unit >> 3) & 15, kb = unit & 7;
    const int tid = otid(), lane = tid & 63, r = lane & 31, h = lane >> 5;
    const int w = __builtin_amdgcn_readfirstlane(tid >> 6);
    const float* wq = wq_all + (size_t)l * D_ * 2048 + (size_t)(kb * 128 + w * 32 + r) * 2048 + hc * 128 + 8 * h;
    const float* ky = keys_all + ((size_t)l * 16 + hc) * 128 * 128 + (size_t)r * 128 + 8 * h;
    const float g2 = g2_all[(size_t)l * D_ + kb * 128 + w * 32 + r];
    bf16x8 af[8];
#pragma unroll
    for (int ks = 0; ks < 8; ++ks) {
        const float4 a = *(const float4*)(wq + 16 * ks), b = *(const float4*)(wq + 16 * ks + 4);
        u32x4 o; o[0] = pk2(a.x * g2, a.y * g2); o[1] = pk2(a.z * g2, a.w * g2); o[2] = pk2(b.x * g2, b.y * g2); o[3] = pk2(b.z * g2, b.w * g2);
        af[ks] = __builtin_bit_cast(bf16x8, o);
    }
    unsigned char* dst = (unsigned char*)wt_all + (size_t)l * 2048 * D_ + ((size_t)(kb * 2 + (w >> 1)) * 2048 + hc * 128 + r) * 64 + (w & 1) * 32 + 4 * h;
#pragma unroll 1
    for (int nt = 0; nt < 4; ++nt) {
        f32x16 acc;
#pragma unroll
        for (int e = 0; e < 16; ++e) acc[e] = 0.f;
#pragma unroll
        for (int ks = 0; ks < 8; ++ks) {
            const float4 a = *(const float4*)(ky + (size_t)nt * 32 * 128 + 16 * ks), b = *(const float4*)(ky + (size_t)nt * 32 * 128 + 16 * ks + 4);
            u32x4 o; o[0] = pk2(a.x, a.y); o[1] = pk2(a.z, a.w); o[2] = pk2(b.x, b.y); o[3] = pk2(b.z, b.w);
            acc = MFMA32(af[ks], __builtin_bit_cast(bf16x8, o), acc);
        }
#pragma unroll
        for (int g = 0; g < 4; ++g) {
            int w8 = __builtin_amdgcn_cvt_pk_fp8_f32(acc[4 * g] * 64.f, acc[4 * g + 1] * 64.f, 0, false);
            w8 = __builtin_amdgcn_cvt_pk_fp8_f32(acc[4 * g + 2] * 64.f, acc[4 * g + 3] * 64.f, w8, true);
            *(int*)(dst + (size_t)nt * 32 * 64 + 8 * g) = w8;
        }
    }
}
struct EpiScore {
    float* TOPK;
    __device__ __forceinline__ void operator()(f32x16 (&acc)[4][2], int abase, int bbase, int r, int h, char* xl, int wa, int wb) const {
        const int hc = abase >> 7;
        { const int l2 = otid() & 63; r = l2 & 31; h = l2 >> 5; }
#pragma unroll
        for (int j = 0; j < 2; ++j) {
            float v[64], keep[16];
#pragma unroll
            for (int hf = 0; hf < 2; ++hf) {
#pragma unroll
                for (int i = 0; i < 2; ++i)
#pragma unroll
                    for (int e = 0; e < 16; ++e)
                        v[16 * i + e] = __uint_as_float((__float_as_uint(acc[2 * hf + i][j][e]) & 0xFFFFFF80u) | (unsigned)(32 * (2 * hf + i) + (e & 3) + 8 * (e >> 2) + 4 * h));
                sort16_desc<0>(v); sort16_desc<16>(v); merge_top16<0, 16>(v);
                if (hf == 0) {
#pragma unroll
                    for (int i = 0; i < 16; ++i) keep[i] = v[i];
                } else {
#pragma unroll
                    for (int i = 0; i < 16; ++i) v[16 + i] = keep[i];
                    merge_top16<0, 16>(v);
                }
            }
#pragma unroll
            for (int i = 0; i < 16; ++i) { float lo, hi2; swap32(v[i], lo, hi2); v[16 + i] = h ? lo : hi2; }
            merge_top16<0, 16>(v);
            const int token = bbase + 32 * j + r;
            float4* dp = (float4*)(TOPK + ((size_t)token * 16 + hc) * 16 + 8 * h);
            if (h == 0) { dp[0] = make_float4(v[0], v[1], v[2], v[3]); dp[1] = make_float4(v[4], v[5], v[6], v[7]); }
            else { dp[0] = make_float4(v[8], v[9], v[10], v[11]); dp[1] = make_float4(v[12], v[13], v[14], v[15]); }
        }
    }
};
__device__ __forceinline__ void d_peer_cand(const size_t pidx, const float* __restrict__ topk, int* idx, float* gate) {
    const float4* tp = (const float4*)(topk + pidx * 32);
    float top[2][16];
#pragma unroll
    for (int c = 0; c < 2; ++c)
#pragma unroll
        for (int q = 0; q < 4; ++q) { const float4 t4 = tp[4 * c + q]; top[c][4 * q] = t4.x; top[c][4 * q + 1] = t4.y; top[c][4 * q + 2] = t4.z; top[c][4 * q + 3] = t4.w; }
    float cd[64];
    {
        unsigned i1[16], i2[16];
#pragma unroll
        for (int i = 0; i < 16; ++i) { i1[i] = (__float_as_uint(top[0][i]) & 127u) << 7; i2[i] = __float_as_uint(top[1][i]) & 127u; }
#define CAND_(i, j) __uint_as_float((__float_as_uint(top[0][i] + top[1][j]) & 0xFFFFC000u) | i1[i] | i2[j])
#pragma unroll
        for (int q = 0; q < 16; ++q) { cd[q] = CAND_(0, q); cd[32 + q] = (q < 15) ? CAND_((q < 15 ? q + 1 : 15), 0) : -INFINITY; }
        int n = 0;
#pragma unroll
        for (int i = 1; i < 8; ++i)
#pragma unroll
            for (int jj = 1; jj < 8; ++jj)
                if ((i + 1) * (jj + 1) <= 16) { if (n < 16) cd[16 + n] = CAND_(i, jj); else cd[48 + n - 16] = CAND_(i, jj); ++n; }
#undef CAND_
#pragma unroll
        for (int q = 3; q < 16; ++q) cd[48 + q] = -INFINITY;
    }
    sort16_desc<16>(cd); merge_top16<0, 16>(cd);
    sort16_desc<48>(cd); merge_top16<32, 48>(cd);
#pragma unroll
    for (int i = 0; i < 16; ++i) cd[i] = fmaxf(cd[i], cd[47 - i]);
    float gv[16]; int ids[16];
    const float vmax = __uint_as_float(__float_as_uint(top[0][0] + top[1][0]) & 0xFFFFC000u);
#pragma unroll
    for (int i = 0; i < 16; ++i) {
        const unsigned b = __float_as_uint(cd[i]);
        ids[i] = (int)(b & 0x3FFFu);
        gv[i] = (__uint_as_float(b & 0xFFFFC000u) - vmax) * (1.f / 64.f);
    }
    int4* ip = (int4*)(idx + pidx * 16); float4* gp = (float4*)(gate + pidx * 16);
#pragma unroll
    for (int i = 0; i < 4; ++i) {
        ip[i] = make_int4(ids[4 * i], ids[4 * i + 1], ids[4 * i + 2], ids[4 * i + 3]);
        gp[i] = make_float4(gv[4 * i], gv[4 * i + 1], gv[4 * i + 2], gv[4 * i + 3]);
    }
}
constexpr int ROUTE_LDS = 65536;
__device__ __forceinline__ void d_peer_route3(const int bid, const int G, const bfu* __restrict__ pq, const bfu* __restrict__ keys, int* __restrict__ idx, float* __restrict__ gate, char* lds) {
    const int hd = bid & 7, tb0 = bid >> 3, tstep = G >> 3, NTB = T_ / 128;
    if (tb0 >= NTB) return;
    const int tid = otid();
    const int wid = __builtin_amdgcn_readfirstlane(tid >> 6);
    bf16x8 qf0[8];
    {
        const int lane = tid & 63;
        const bfu* qrow = pq + ((size_t)(hd * 32 + (lane >> 5)) * T_ + tb0 * 128 + wid * 32 + (lane & 31)) * 8;
#pragma unroll
        for (int ks = 0; ks < 8; ++ks) qf0[ks] = *(const bf16x8*)(qrow + (size_t)(2 * ks) * T_ * 8);
    }
    __syncthreads();
    {
        const bfu* kg = keys + (size_t)hd * 2 * 128 * 128;
#pragma unroll
        for (int it = 0; it < 16; ++it) {
            const int cidx = tid + 256 * it, n = cidx >> 4, ch = cidx & 15;
            *(u32x4*)(lds + n * 256 + ((ch ^ (n & 15)) << 4)) = *(const u32x4*)(kg + (size_t)cidx * 8);
        }
    }
    __syncthreads();
#pragma unroll 1
    for (int tb = tb0; tb < NTB; tb += tstep) {
        const int lane = otid() & 63, r = lane & 31, h = lane >> 5;
        const bfu* qbase = pq + ((size_t)(hd * 32 + h) * T_ + wid * 32 + r) * 8;
        const int t = tb * 128 + wid * 32 + r;
        const int tbn = (tb + tstep < NTB) ? tb + tstep : tb;
        float top[2][16];
        bf16x8 qf1[8];
        {
            const bfu* qrow = qbase + (size_t)tb * 128 * 8;
#pragma unroll
            for (int ks = 0; ks < 8; ++ks) qf1[ks] = *(const bf16x8*)(qrow + (size_t)(16 + 2 * ks) * T_ * 8);
        }
#pragma unroll
        for (int c = 0; c < 2; ++c) {
            float v[64];
#pragma unroll
            for (int mt = 0; mt < 4; ++mt) {
                f32x16 acc;
#pragma unroll
                for (int e = 0; e < 16; ++e) acc[e] = 0.f;
                const char* kb = lds + c * 32768 + (32 * mt + r) * 256;
#pragma unroll
                for (int ks = 0; ks < 8; ++ks) acc = MFMA32(*(const bf16x8*)(kb + (((2 * ks + h) ^ (r & 15)) << 4)), c ? qf1[ks] : qf0[ks], acc);
#pragma unroll
                for (int e = 0; e < 16; ++e) {
                    const unsigned n = (unsigned)(32 * mt + (e & 3) + 8 * (e >> 2)) | (unsigned)(4 * h);
                    v[16 * mt + e] = __uint_as_float((__float_as_uint(acc[e]) & 0xFFFFFF80u) | n);
                }
            }
            if (c) {
                const bfu* qrow = qbase + (size_t)tbn * 128 * 8;
#pragma unroll
                for (int ks = 0; ks < 8; ++ks) qf0[ks] = *(const bf16x8*)(qrow + (size_t)(2 * ks) * T_ * 8);
            }
            top16_of_64(v);
#pragma unroll
            for (int i = 0; i < 16; ++i) { float lo, hi2; swap32(v[i], lo, hi2); v[16 + i] = h ? lo : hi2; }
            merge_top16<0, 16>(v);
#pragma unroll
            for (int i = 0; i < 16; ++i) top[c][i] = v[i];
        }
        float cd[64];
        {
            unsigned i1[16], i2[16];
#pragma unroll
            for (int i = 0; i < 16; ++i) { i1[i] = (__float_as_uint(top[0][i]) & 127u) << 7; i2[i] = __float_as_uint(top[1][i]) & 127u; }
#define CAND_(i, j) __uint_as_float((__float_as_uint(top[0][i] + top[1][j]) & 0xFFFFC000u) | i1[i] | i2[j])
#pragma unroll
            for (int q = 0; q < 16; ++q) {
                const float a = CAND_(0, q), b = (q < 15) ? CAND_((q < 15 ? q + 1 : 15), 0) : -INFINITY;
                cd[q] = h ? b : a;
            }
            float cx[19];
            {
                int n = 0;
#pragma unroll
                for (int i = 1; i < 8; ++i)
#pragma unroll
                    for (int jj = 1; jj < 8; ++jj)
                        if ((i + 1) * (jj + 1) <= 16) { cx[n] = CAND_(i, jj); ++n; }
            }
#undef CAND_
#pragma unroll
            for (int q = 0; q < 16; ++q) cd[16 + q] = h ? (q < 3 ? cx[16 + q] : -INFINITY) : cx[q];
        }
        sort16_desc<16>(cd);
        merge_top16<0, 16>(cd);
#pragma unroll
        for (int i = 0; i < 16; ++i) { float lo, hi2; swap32(cd[i], lo, hi2); cd[16 + i] = lo; cd[32 + i] = hi2; }
#pragma unroll
        for (int i = 0; i < 16; ++i) cd[i] = fmaxf(cd[16 + i], cd[47 - i]);
        float gsum = 0.f; float gv[16]; int ids[16];
        const float vmax = __uint_as_float(__float_as_uint(top[0][0] + top[1][0]) & 0xFFFFC000u);
#pragma unroll
        for (int i = 0; i < 16; ++i) {
            const unsigned b = __float_as_uint(cd[i]);
            ids[i] = (int)(b & 0x3FFFu);
            gv[i] = __expf(__uint_as_float(b & 0xFFFFC000u) - vmax); gsum += gv[i];
        }
        const float ginv = 1.f / gsum;
        if (h == 0) {
            int4* ip = (int4*)(idx + (size_t)t * 128 + hd * 16);
#pragma unroll
            for (int i = 0; i < 4; ++i) ip[i] = make_int4(ids[4 * i], ids[4 * i + 1], ids[4 * i + 2], ids[4 * i + 3]);
        } else {
            float4* gp = (float4*)(gate + (size_t)t * 128 + hd * 16);
#pragma unroll
            for (int i = 0; i < 4; ++i) gp[i] = make_float4(gv[4 * i] * ginv, gv[4 * i + 1] * ginv, gv[4 * i + 2] * ginv, gv[4 * i + 3] * ginv);
        }
    }
}

struct Params {
    const float* in[19];
    float* out;
    char* ws;
    int ph_lo, ph_hi;
};
constexpr size_t al256(size_t x) { return (x + 255) & ~(size_t)255; }
constexpr size_t WS_BAR = 0;
constexpr size_t WS_A = al256(XCD_BAR_WORDS * 4);
constexpr size_t WS_GI = WS_A + al256((size_t)T_ * D_ * 2);
constexpr size_t WS_GLF = WS_GI + al256((size_t)T_ * 6 * 4);
constexpr size_t WS_IDX = WS_GLF + al256((size_t)T_ * 6 * 4);
constexpr size_t WS_GATE = WS_IDX + al256((size_t)T_ * 128 * 4);
constexpr int NIN = 3200;
constexpr size_t WS_WTIN = WS_GATE + al256((size_t)T_ * 128 * 4);
constexpr size_t WS_WTOUT = WS_WTIN + al256((size_t)DEPTH_ * NIN * D_ * 2);
constexpr size_t WS_WTQ = WS_WTOUT + al256((size_t)DEPTH_ * D_ * D_ * 2);
constexpr size_t WS_TU = WS_WTQ + al256((size_t)DEPTH_ * 2048 * D_ * 2);
constexpr size_t WS_TV = WS_TU + al256((size_t)16384 * D_ * 2);
constexpr size_t WS_SBQ = WS_TV + al256((size_t)16384 * D_ * 2);
constexpr size_t WS_MLQ = WS_SBQ + al256((size_t)3 * T_ * 384 * 2);
constexpr size_t WS_MLO = WS_MLQ + al256((size_t)3 * T_ * 384 * 2);
constexpr size_t WS_SGU = WS_MLO + al256((size_t)T_ * 384 * 2);
constexpr size_t WS_SGV = WS_SGU + al256((size_t)T_ * 256 * 2);
constexpr size_t WS_WLOC = WS_SGV + al256((size_t)T_ * 256 * 2);
constexpr size_t WS_NLOC = WS_WLOC + al256((size_t)48 * 32 * 4096 * 4);
constexpr size_t WS_SCAL = WS_NLOC + al256((size_t)48 * 32 * 64 * 4);
constexpr size_t WS_SGW = WS_SCAL + al256((size_t)48 * 32 * 2 * 4);
constexpr size_t WS_WG = WS_SGW + al256((size_t)DEPTH_ * 4 * 128 * 128 * 2);
constexpr size_t WS_PQ = WS_WG + al256((size_t)DEPTH_ * 12 * 1024 * 4);
constexpr size_t WS_KEYS = WS_PQ + al256((size_t)T_ * 2048 * 2);
constexpr size_t WS_USC = WS_KEYS + al256((size_t)DEPTH_ * 8 * 2 * 128 * 128 * 2);
constexpr size_t WS_VSC = WS_USC + al256(16384 * 4);
constexpr size_t WS_B = WS_VSC + al256(16384 * 4);
constexpr size_t WS_END = WS_B + al256((size_t)T_ * D_ * 2);
constexpr size_t WS_TAB = WS_END;
constexpr size_t WS_TSC = WS_TAB + (size_t)DEPTH_ * 16384 * 1024;
constexpr size_t WS_END2 = WS_TSC + (size_t)DEPTH_ * 2 * 16384 * 4;
constexpr int NPH = 9;
constexpr int LDS_BYTES = 16 + GEMM_LDS;
static_assert(MLB_LDS <= GEMM_LDS && MLA_LDS <= GEMM_LDS && SBA_LDS + 32 <= GEMM_LDS, "lds");

__global__ void __launch_bounds__(256, 2) mk_fwd(Params p) {
    extern __shared__ __attribute__((aligned(16))) char lds[];
    if (threadIdx.x == 0) *(uint4*)lds = make_uint4(0u, 0u, 0u, 0u);
    __syncthreads();
    XcdBarrier bar = xcd_barrier_post((unsigned*)(p.ws + WS_BAR), (volatile LAS unsigned*)lds);
    float* sm = (float*)(lds + 16);
    char* smc = lds + 16;
    const int G = gridDim.x; int bid = blockIdx.x; bool uni = false;
    float* topk = (float*)(p.ws + WS_PQ);
    unsigned char* x8 = (unsigned char*)(p.ws + WS_PQ + ((size_t)64 << 20));
    unsigned char* wt8 = (unsigned char*)(p.ws + WS_WTQ);
    bfu* bufA = (bfu*)(p.ws + WS_A); bfu* bufB = (bfu*)(p.ws + WS_B);
    float* gi = (float*)(p.ws + WS_GI); float* glf = (float*)(p.ws + WS_GLF);
    int* idx = (int*)(p.ws + WS_IDX); float* gate = (float*)(p.ws + WS_GATE);
    bfu* wtin = (bfu*)(p.ws + WS_WTIN); bfu* wtout = (bfu*)(p.ws + WS_WTOUT); bfu* wtq = (bfu*)(p.ws + WS_WTQ);
    unsigned char* tu = (unsigned char*)(p.ws + WS_TU); unsigned char* tv = (unsigned char*)(p.ws + WS_TV); float* usc = (float*)(p.ws + WS_USC); float* vsc = (float*)(p.ws + WS_VSC);
    bfu* sbq = (bfu*)(p.ws + WS_SBQ); bfu* sbk = sbq + (size_t)T_ * 384; bfu* sbv = sbk + (size_t)T_ * 384;
    bfu* mlq = (bfu*)(p.ws + WS_MLQ); bfu* mlk = mlq + (size_t)T_ * 384; bfu* mlv = mlk + (size_t)T_ * 384;
    bfu* mlo = (bfu*)(p.ws + WS_MLO); bfu* sgu = (bfu*)(p.ws + WS_SGU); bfu* sgv = (bfu*)(p.ws + WS_SGV);
    float* wloc = (float*)(p.ws + WS_WLOC); float* nloc = (float*)(p.ws + WS_NLOC); float* scal = (float*)(p.ws + WS_SCAL);
    bfu* sgw = (bfu*)(p.ws + WS_SGW); float* wgc = (float*)(p.ws + WS_WG);
    float* xo = p.out;
    const int lo = p.ph_lo, hi = p.ph_hi;
#ifndef DUP_MASK
#define DUP_MASK 0
#endif
#define DUPK(ph) ((ph) == 0 ? 0 : 1 + ((ph) - 1) % NPH)
#define PHASE_ID(ph, NB, ...) { const int ph_ = (ph); if (lo <= ph_ && ph_ < hi) { for (int rep_ = 0; rep_ <= ((DUP_MASK >> DUPK(ph_)) & 1); ++rep_) for (int vb = bid; vb < (NB); vb += G) { __VA_ARGS__; } if (ph_ + 1 < hi) xcd_barrier(bar); } }
#define PHASE(k, NB, ...) PHASE_ID(1 + l * NPH + (k), NB, __VA_ARGS__)
#define GEMM_PHASE(k, NTT, NFT, TOKA, AP, BP, RSA, KTSA, RSB, KTSB, ...) { const int ph_ = 1 + l * NPH + (k); if (lo <= ph_ && ph_ < hi) { \
        __VA_ARGS__; const UnitMap um_{bid & 7, (NTT), (NFT), (TOKA)}; const OpLay ol_{(RSA), (KTSA), (RSB), (KTSB)}; \
        for (int rep_ = 0; rep_ <= ((DUP_MASK >> DUPK(ph_)) & 1); ++rep_) gemm_stream<false, 0>((AP), (BP), smc, e, um_, ol_, bid >> 3, G >> 3); \
        if (ph_ + 1 < hi) grp_barrier(bar, uni); } }
    if (lo <= 0 && 0 < hi) {
        __syncthreads();
        for (int e = otid(); e < 3072; e += 256) {
            const int k = e / 3, q = e - 3 * k;
            const float4 w4 = *(const float4*)(p.in[2] + (size_t)k * INW + ZMI + 4 * q);
            sm[(4 * q) * 1024 + k] = w4.x; sm[(4 * q + 1) * 1024 + k] = w4.y; sm[(4 * q + 2) * 1024 + k] = w4.z; sm[(4 * q + 3) * 1024 + k] = w4.w;
        }
        __syncthreads();
        for (int rep_ = 0; rep_ <= ((DUP_MASK >> 1) & 1); ++rep_) for (int vb = bid; vb < T_ / 4; vb += G) d_rmsnorm<true>(vb, p.in[0], p.in[1], bufA, nullptr, sm, p.in[7], p.in[8], gi, glf);
        for (int rep_ = 0; rep_ <= (DUP_MASK & 1); ++rep_) for (int vb = bid; vb < DEPTH_ * (800 + 256) + 128 + 16 + 512; vb += G) {
            if (vb < DEPTH_ * 1056) {
                const int l = vb / 1056, u = vb % 1056;
                if (u < 800) d_transpose_w<true>(u, p.in[2] + (size_t)l * D_ * INW, wtin + (size_t)l * NIN * D_, INW, 50, sm);
                else d_transpose_w<false>(u - 800, p.in[13] + (size_t)l * D_ * D_, wtout + (size_t)l * D_ * D_, D_, 16, sm);
            } else if (vb < DEPTH_ * 1056 + 128) d_cvt_sgw(vb - DEPTH_ * 1056, p.in[10], sgw);
            else if (vb < DEPTH_ * 1056 + 144) d_gatew(vb - DEPTH_ * 1056 - 128, p.in[2], wgc);
            else d_compose_wq(vb - DEPTH_ * 1056 - 144, p.in[15], p.in[16], p.in[14], wtq);
        }
        if (1 < hi) xcd_barrier(bar);
    }
    if (lo == 0 && 1 < hi) {
        if (threadIdx.x == 0) {
            bool ok = (G & 7) == 0;
#pragma unroll
            for (unsigned j = 0; j < 16; ++j) { const unsigned c = xb_ld(&bar.bar[XB_XCNT(j)]); ok = ok && (c == (j < 8 ? (unsigned)(G >> 3) : 0u)); }
            bar.st[3] = ok ? 1u : 0u;
        }
        __syncthreads();
        uni = __builtin_amdgcn_readfirstlane((int)bar.st[3]) != 0;
        if (uni) bid = __builtin_amdgcn_readfirstlane((int)bar.st[2]) * 8 + (int)bar.x;
    }
    const int grp = bid & 7, rk = bid >> 3, gstep = G >> 3;
    for (int l = 0; l < DEPTH_; ++l) {
        unsigned char* tul = (unsigned char*)(p.ws + WS_TAB) + (size_t)l * 16384 * 1024;
        float* uscl = (float*)(p.ws + WS_TSC) + (size_t)l * 2 * 16384;
        unsigned* cvcnt = bar.bar + XB_CVT + 32 * l;
        const float* xcur = (l == 0) ? p.in[0] : xo;
        const float* og = p.in[12] + (size_t)l * D_;
        const float* cw = p.in[5] + (size_t)l * 4 * 768; const float* cb = p.in[6] + l * 768;
        {
            const int ph_ = 1 + l * NPH + 1;
            if (lo <= ph_ && ph_ < hi) {
                const EpiIn e{p.in[3] + l * 64, p.in[4] + l * 64, p.in[9] + l * 256, sbq, sbk, sbv, mlq, mlk, mlv, mlo, sgu, sgv};
                const UnitMap um_{bid & 7, 16, 25, 0}; const OpLay ol_{32, NIN * 32, 32, T_ * 32};
                const int rkg = (rk < 32 && gstep >= 32) ? ((rk & 1) ? 16 + (rk >> 1) : (rk >> 1)) : rk;
                for (int rep_ = 0; rep_ <= ((DUP_MASK >> DUPK(ph_)) & 1); ++rep_) gemm_stream<false, 0>(wtin + (size_t)l * NIN * D_, bufA, smc, e, um_, ol_, rkg, G >> 3);
                const int step = G >> 3, maxu = (400 + step - 1) / step, thr = 400 - (maxu - 1) * step;
                int rank = bid, nb = G;
                if (thr < step) { rank = (rkg - thr) * 8 + (bid & 7); nb = (step - thr) * 8; }
                if (rank >= 0)
                    for (int vb = rank; vb < 4096; vb += nb) {
                        if (vb < 2048) d_cvt_i4x2<true>(vb, p.in[17] + (size_t)l * 16384 * D_, tul, uscl, p.in[14] + (size_t)l * D_);
                        else d_cvt_i4x2<false>(vb - 2048, p.in[18] + (size_t)l * 16384 * D_, tul + 8, uscl + 1, nullptr);
                    }
                asm volatile("s_waitcnt vmcnt(0)" ::: "memory");
                __syncthreads();
                if (threadIdx.x == 0) {
                    const unsigned old = xb_add(cvcnt + 1 + bar.x, 1u);
                    if (old + 1u == bar.st[0]) {
                        __builtin_amdgcn_fence(__ATOMIC_RELEASE, "agent");
                        asm volatile("s_waitcnt vmcnt(0)" ::: "memory");
                        (void)xb_add(cvcnt, 1u);
                    }
                }
                if (ph_ + 1 < hi) grp_barrier(bar, uni);
            }
        }
        {
            const int ph_ = 1 + l * NPH + 2;
            if (lo <= ph_ && ph_ < hi) {
                unsigned* mlcnt = bar.bar + 32 * l;
                for (int v = rk; v < 192; v += gstep) d_ml_a(grp * 192 + v, mlk, mlv, gi, glf, cw, cb, wloc, nloc, scal, smc);
                asm volatile("s_waitcnt vmcnt(0)" ::: "memory");
                __syncthreads();
                if (threadIdx.x == 0) {
                    const unsigned nl = bar.st[0];
                    const unsigned old = xb_add(mlcnt + 1 + bar.x, 1u);
                    if (!uni && old + 1u == nl) {
                        __builtin_amdgcn_fence(__ATOMIC_RELEASE, "agent");
                        asm volatile("s_waitcnt vmcnt(0)" ::: "memory");
                        (void)xb_add(mlcnt, 1u);
                    }
                }
                {
                    unsigned* dynq = bar.bar + XB_DYN + 16 * l + grp;
                    bool waited = false;
                    int item = rk, par = 0;
                    while (item < 512) {
                        unsigned nx_ = 0u;
                        if (threadIdx.x == 0) nx_ = xb_add(dynq, 1u) + (unsigned)gstep;
                        if (item < 192) d_sb_attn2((item / 6) * 48 + grp * 6 + item % 6, sbq, sbk, sbv, og, bufA, smc);
                        else if (item < 384) {
                            if (!waited) {
                                __syncthreads();
                                if (threadIdx.x == 0) {
                                    if (uni) XB_SPIN(xb_ld(mlcnt + 1 + bar.x) < bar.st[0], bar.bar);
                                    else XB_SPIN(xb_ld(mlcnt) < bar.st[1], bar.bar);
                                    __builtin_amdgcn_fence(__ATOMIC_ACQUIRE, "agent");
                                    asm volatile("s_waitcnt vmcnt(0)" ::: "memory");
                                }
                                __syncthreads();
                                waited = true;
                            }
                            const int v = item - 192;
                            d_ml_b((v / 6) * 48 + grp * 6 + v % 6, mlq, mlk, mlv, mlo, gi, glf, cw, cb, wloc, nloc, scal, og, bufA, smc);
                        } else d_sg2(grp * 128 + item - 384, sgu, sgv, sgw + (size_t)l * 4 * 128 * 128, p.in[11] + l * 4 * 128, og, bufA, smc);
                        if (threadIdx.x == 0) bar.st[2 + par] = nx_;
                        __syncthreads();
                        item = __builtin_amdgcn_readfirstlane((int)bar.st[2 + par]);
                        par ^= 1;
                    }
                }
                if (ph_ + 1 < hi) grp_barrier(bar, uni);
            }
        }
        GEMM_PHASE(4, 32, 4, 1, bufA, wtout + (size_t)l * D_ * D_, 32, T_ * 32, 32, D_ * 32, const EpiOut e{xcur, xo, bufB, x8})
        {
            const int ph_ = 1 + l * NPH + 6;
            if (lo <= ph_ && ph_ < hi) {
                const EpiScore e{topk}; const UnitMap um_{bid & 7, 16, 16, 0}; const OpLay ol_{32, 2048 * 32, 32, T_ * 32};
                for (int rep_ = 0; rep_ <= ((DUP_MASK >> DUPK(ph_)) & 1); ++rep_)
                    gemm_stream<true, 1>((const bfu*)(wt8 + (size_t)l * 2048 * D_), (const bfu*)x8, smc, e, um_, ol_, bid >> 3, G >> 3);
                if (ph_ + 1 < hi) grp_barrier(bar, uni);
            }
        }
        {
            const int ph_ = 1 + l * NPH + 8;
            if (lo <= ph_ && ph_ < hi) {
                for (int q = 0;; ++q) {
                    const int pl = otid() + 256 * q, tl = pl >> 3, vq = rk + gstep * (tl >> 2), vbq = grp * 1024 + vq;
                    if (vq >= 1024) break;
                    d_peer_cand((size_t)(vbq * 4 + (tl & 3)) * 8 + (pl & 7), topk, idx, gate);
                }
                if (threadIdx.x == 0) {
                    XB_SPIN(xb_ld(cvcnt) < bar.st[1], bar.bar);
                    __builtin_amdgcn_fence(__ATOMIC_ACQUIRE, "agent");
                    asm volatile("s_waitcnt vmcnt(0)" ::: "memory");
                }
                __syncthreads();
                if (l + 1 < DEPTH_) {
                    __syncthreads();
                    for (int e = otid(); e < 3072; e += 256) *(float4*)(sm + e * 4) = *(const float4*)(wgc + (size_t)(l + 1) * 12288 + e * 4);
                    __syncthreads();
                    for (int v = rk; v < 1024; v += gstep)
                        d_peer_expert5<true>(grp * 1024 + v, bufB, bufA, idx, gate, tul, tv, uscl, vsc, xo, p.in[1] + (size_t)(l + 1) * D_, sm, p.in[7] + (l + 1) * 6, p.in[8] + (l + 1) * 6, gi, glf);
                } else {
                    for (int v = rk; v < 1024; v += gstep) d_peer_expert5<false>(grp * 1024 + v, bufB, bufA, idx, gate, tul, tv, uscl, vsc, xo, nullptr, nullptr, nullptr, nullptr, nullptr, nullptr);
                }
                if (ph_ + 1 < hi) grp_barrier(bar, uni);
            }
        }
    }
}

extern "C" void kernel_launch(void* const* d_in, const int* in_sizes, int n_in, void* d_out, int out_size, void* d_ws, size_t ws_size, hipStream_t stream) {
    static int grid = 0;
    if (grid == 0) {
        int dev = 0, cus = 0, per_cu = 0;
        (void)hipGetDevice(&dev);
        (void)hipDeviceGetAttribute(&cus, hipDeviceAttributeMultiprocessorCount, dev);
        (void)hipFuncSetAttribute((const void*)mk_fwd, hipFuncAttributeMaxDynamicSharedMemorySize, LDS_BYTES);
        (void)hipOccupancyMaxActiveBlocksPerMultiprocessor(&per_cu, (const void*)mk_fwd, 256, LDS_BYTES);
        if (per_cu < 1) per_cu = 1;
        if (per_cu > 2) per_cu = 2;
        if (cus <= 0) cus = 256;
        grid = cus * per_cu;
        grid -= grid % 8;
        if (grid < 8) grid = 8;
        (void)hipGetLastError();
    }
    if (ws_size < WS_END2) return;
    (void)hipMemsetAsync((char*)d_ws + WS_BAR, 0, XCD_BAR_WORDS * 4, stream);
    Params p{};
    for (int i = 0; i < 19; ++i) p.in[i] = (const float*)d_in[i];
    p.out = (float*)d_out; p.ws = (char*)d_ws; p.ph_lo = 0; p.ph_hi = 1 + DEPTH_ * NPH;
    hipLaunchKernelGGL(mk_fwd, dim3(grid), dim3(256), LDS_BYTES, stream, p);
}
```
